# Optimizing an MI355X kernel written in HIP

```python
import math
import jax, jax.numpy as jnp
from jax import lax
import numpy as np

D_MODEL = 4096
BATCH = 4
SEQ = 2048
DEPTH = 1

MIX_WIDTH = D_MODEL
ATTN_WIDTH = MIX_WIDTH // 2
SSM_WIDTH = MIX_WIDTH - ATTN_WIDTH
HEAD_DIM = 128
ATTN_HEADS = ATTN_WIDTH // HEAD_DIM
MOBA_BLOCK = 256
MOBA_TOPK = 3
QUERY_CHUNK = 32
NUM_BUCKETS = 32
MAX_DISTANCE = 128
SSM_GROUP_CH = 16
SSM_GROUPS = SSM_WIDTH // SSM_GROUP_CH
SSM_STATE = 64
IN_PROJ_WIDTH = 3 * ATTN_WIDTH + SSM_WIDTH
PEER_HEADS = 8
PEER_NKEYS = 128
PEER_EXPERTS = PEER_NKEYS * PEER_NKEYS
PEER_TOPK = 16
PEER_QDIM = 256
PEER_TOKEN_CHUNK = 128
PEER_V_SCALE = 0.25
RMS_EPS = 1e-6
NEG_INF = -1e30

kernel_name = 'hymba_moba_s5_peer_block'


def rmsnorm(x, gain):
    xf = x.astype(jnp.float32)
    y = xf * lax.rsqrt(jnp.mean(xf * xf, axis=-1, keepdims=True) + RMS_EPS)
    return (y * gain.astype(jnp.float32)).astype(x.dtype)


def t5_bucket(dist):
    n = jnp.maximum(dist, 0)
    max_exact = NUM_BUCKETS // 2
    ratio = jnp.log(jnp.maximum(n, 1).astype(jnp.float32) / max_exact) / math.log(MAX_DISTANCE / max_exact)
    large = max_exact + (ratio * (NUM_BUCKETS - max_exact)).astype(jnp.int32)
    large = jnp.minimum(large, NUM_BUCKETS - 1)
    return jnp.where(n < max_exact, n, large)


def moba_attention(q, k, v, rel_bias):
    Bsz, S, H, Dh = q.shape
    nb = -(-S // MOBA_BLOCK)
    pad = nb * MOBA_BLOCK - S
    q = q.transpose(0, 2, 1, 3)
    kp = jnp.pad(k.transpose(0, 2, 1, 3), ((0, 0), (0, 0), (0, pad), (0, 0))).reshape(Bsz, H, nb, MOBA_BLOCK, Dh)
    vp = jnp.pad(v.transpose(0, 2, 1, 3), ((0, 0), (0, 0), (0, pad), (0, 0))).reshape(Bsz, H, nb, MOBA_BLOCK, Dh)
    kmean = jnp.mean(kp.astype(jnp.float32), axis=3)
    qblk = jnp.arange(S) // MOBA_BLOCK
    gate = jnp.einsum('bhsd,bhnd->bhsn', q.astype(jnp.float32), kmean)
    past = jnp.arange(nb)[None, :] < qblk[:, None]
    gate = jnp.where(past, gate, NEG_INF)
    ktop = min(MOBA_TOPK, nb)
    _, sel = lax.top_k(gate, ktop)
    valid = sel < qblk[None, None, :, None]
    nq = S // QUERY_CHUNK
    scale = Dh ** -0.5
    hidx = jnp.arange(H)[:, None, None]
    offs = jnp.arange(MOBA_BLOCK)

    def one_chunk(i):
        b = i // nq
        q0 = (i % nq) * QUERY_CHUNK
        qc = lax.dynamic_slice_in_dim(q[b], q0, QUERY_CHUNK, axis=1)
        kb, vb = kp[b], vp[b]
        selc = lax.dynamic_slice_in_dim(sel[b], q0, QUERY_CHUNK, axis=1)
        validc = lax.dynamic_slice_in_dim(valid[b], q0, QUERY_CHUNK, axis=1)
        ksel = kb[hidx, selc]
        vsel = vb[hidx, selc].reshape(H, QUERY_CHUNK, ktop * MOBA_BLOCK, Dh)
        own = q0 // MOBA_BLOCK
        kown = lax.dynamic_index_in_dim(kb, own, axis=1, keepdims=False)
        vown = lax.dynamic_index_in_dim(vb, own, axis=1, keepdims=False)
        s_sel = jnp.einsum('hqd,hqnkd->hqnk', qc, ksel).reshape(H, QUERY_CHUNK, ktop * MOBA_BLOCK)
        s_own = jnp.einsum('hqd,hkd->hqk', qc, kown)
        qpos = q0 + jnp.arange(QUERY_CHUNK)
        kpos_sel = (selc[..., None] * MOBA_BLOCK + offs).reshape(H, QUERY_CHUNK, ktop * MOBA_BLOCK)
        kpos_own = own * MOBA_BLOCK + offs
        kpos = jnp.concatenate([kpos_sel, jnp.broadcast_to(kpos_own, (H, QUERY_CHUNK, MOBA_BLOCK))], axis=-1)
        mask_sel = jnp.broadcast_to(validc[..., None], (H, QUERY_CHUNK, ktop, MOBA_BLOCK)).reshape(H, QUERY_CHUNK, ktop * MOBA_BLOCK)
        mask_own = jnp.broadcast_to(kpos_own[None, None, :] <= qpos[None, :, None], (H, QUERY_CHUNK, MOBA_BLOCK))
        mask = jnp.concatenate([mask_sel, mask_own], axis=-1)
        bias = rel_bias[t5_bucket(qpos[None, :, None] - kpos), hidx]
        logits = jnp.concatenate([s_sel, s_own], axis=-1).astype(jnp.float32) * scale + bias.astype(jnp.float32)
        p = jax.nn.softmax(jnp.where(mask, logits, NEG_INF), axis=-1).astype(v.dtype)
        n_sel = ktop * MOBA_BLOCK
        return (jnp.einsum('hqk,hqkd->hqd', p[..., :n_sel], vsel)
                + jnp.einsum('hqk,hkd->hqd', p[..., n_sel:], vown))

    out = lax.map(one_chunk, jnp.arange(Bsz * nq))
    return out.reshape(Bsz, nq, H, QUERY_CHUNK, Dh).transpose(0, 1, 3, 2, 4).reshape(Bsz, S, H * Dh)


def _complex_affine_combine(e1, e2):
    a1r, a1i, b1r, b1i = e1
    a2r, a2i, b2r, b2i = e2
    return (a2r * a1r - a2i * a1i,
            a2r * a1i + a2i * a1r,
            a2r * b1r - a2i * b1i + b2r,
            a2r * b1i + a2i * b1r + b2i)


def s5_mixer(u, lam_re, lam_im, log_dt, b_re, b_im, c_re, c_im, d_skip, w_glu):
    Bsz, S, _ = u.shape
    ug = u.reshape(Bsz, S, SSM_GROUPS, SSM_GROUP_CH)
    dt = jnp.exp(log_dt)[:, None]
    mag = jnp.exp(lam_re * dt)
    ab_re = mag * jnp.cos(lam_im * dt)
    ab_im = mag * jnp.sin(lam_im * dt)
    den = lam_re * lam_re + lam_im * lam_im
    nr, ni = ab_re - 1.0, ab_im
    coef_re = ((nr * lam_re + ni * lam_im) / den)[..., None]
    coef_im = ((ni * lam_re - nr * lam_im) / den)[..., None]
    bb_re = coef_re * b_re - coef_im * b_im
    bb_im = coef_re * b_im + coef_im * b_re
    bu_re = jnp.einsum('bsgc,gpc->bsgp', ug, bb_re)
    bu_im = jnp.einsum('bsgc,gpc->bsgp', ug, bb_im)
    a_re = jnp.broadcast_to(ab_re.astype(bu_re.dtype), bu_re.shape)
    a_im = jnp.broadcast_to(ab_im.astype(bu_re.dtype), bu_re.shape)
    _, _, h_re, h_im = lax.associative_scan(_complex_affine_combine, (a_re, a_im, bu_re, bu_im), axis=1)
    y = jnp.einsum('gcp,bsgp->bsgc', c_re, h_re) - jnp.einsum('gcp,bsgp->bsgc', c_im, h_im)
    y = y.reshape(Bsz, S, SSM_WIDTH) + d_skip * u
    y = jax.nn.gelu(y, approximate=False)
    return y * jax.nn.sigmoid(y @ w_glu)


def peer_ffn(h, w_q, keys_a, keys_b, u_tab, v_tab):
    Bsz, S, D = h.shape
    T = Bsz * S
    ht = h.reshape(T, D)
    q = (ht @ w_q).reshape(T, PEER_HEADS, PEER_QDIM)
    half = PEER_QDIM // 2
    sa = jnp.einsum('thd,hkd->thk', q[..., :half], keys_a).astype(jnp.float32)
    sb = jnp.einsum('thd,hkd->thk', q[..., half:], keys_b).astype(jnp.float32)
    va, ia = lax.top_k(sa, PEER_TOPK)
    vb, ib = lax.top_k(sb, PEER_TOPK)
    cand = (va[..., :, None] + vb[..., None, :]).reshape(T, PEER_HEADS, PEER_TOPK * PEER_TOPK)
    vbest, cbest = lax.top_k(cand, PEER_TOPK)
    ea = jnp.take_along_axis(ia, cbest // PEER_TOPK, axis=-1)
    eb = jnp.take_along_axis(ib, cbest % PEER_TOPK, axis=-1)
    experts = ea * PEER_NKEYS + eb
    gates = jax.nn.softmax(vbest, axis=-1).astype(h.dtype)
    nchunk = T // PEER_TOKEN_CHUNK

    def one_chunk(args):
        xc, ec, gc = args
        act = jax.nn.gelu(jnp.einsum('td,thkd->thk', xc, u_tab[ec]), approximate=False)
        return jnp.einsum('thk,thkd->td', gc * act, v_tab[ec])

    out = lax.map(one_chunk, (ht.reshape(nchunk, PEER_TOKEN_CHUNK, D),
                              experts.reshape(nchunk, PEER_TOKEN_CHUNK, PEER_HEADS, PEER_TOPK),
                              gates.reshape(nchunk, PEER_TOKEN_CHUNK, PEER_HEADS, PEER_TOPK)))
    return out.reshape(Bsz, S, D)


def setup_inputs(seed: int = 0) -> dict:
    key = jax.random.key(seed)
    ks = jax.random.split(key, 24)

    def nrm(k, shape, scale):
        return jax.random.normal(k, shape, jnp.float32) * scale

    n_idx = jnp.arange(SSM_STATE, dtype=jnp.float32)
    return {
        'x': nrm(ks[0], (BATCH, SEQ, D_MODEL), 1.0),
        'norm_mix_gain': 1.0 + nrm(ks[1], (DEPTH, D_MODEL), 0.02),
        'w_in': nrm(ks[2], (DEPTH, D_MODEL, IN_PROJ_WIDTH), D_MODEL ** -0.5),
        'rel_bias': nrm(ks[3], (NUM_BUCKETS, ATTN_HEADS), 0.5),
        'ssm_lambda_re': -0.5 + nrm(ks[4], (DEPTH, SSM_GROUPS, SSM_STATE), 0.01),
        'ssm_lambda_im': math.pi * n_idx + nrm(ks[5], (DEPTH, SSM_GROUPS, SSM_STATE), 0.01),
        'ssm_log_dt': jax.random.uniform(ks[6], (DEPTH, SSM_GROUPS), jnp.float32, math.log(1e-3), math.log(1e-1)),
        'ssm_b_re': nrm(ks[7], (DEPTH, SSM_GROUPS, SSM_STATE, SSM_GROUP_CH), (2 * SSM_GROUP_CH) ** -0.5),
        'ssm_b_im': nrm(ks[8], (DEPTH, SSM_GROUPS, SSM_STATE, SSM_GROUP_CH), (2 * SSM_GROUP_CH) ** -0.5),
        'ssm_c_re': nrm(ks[9], (DEPTH, SSM_GROUPS, SSM_GROUP_CH, SSM_STATE), (2 * SSM_STATE) ** -0.5),
        'ssm_c_im': nrm(ks[10], (DEPTH, SSM_GROUPS, SSM_GROUP_CH, SSM_STATE), (2 * SSM_STATE) ** -0.5),
        'ssm_d': nrm(ks[11], (DEPTH, SSM_WIDTH), 1.0),
        'ssm_w_glu': nrm(ks[12], (DEPTH, SSM_WIDTH, SSM_WIDTH), SSM_WIDTH ** -0.5),
        'attn_out_gain': 1.0 + nrm(ks[13], (DEPTH, ATTN_WIDTH), 0.02),
        'ssm_out_gain': 1.0 + nrm(ks[14], (DEPTH, SSM_WIDTH), 0.02),
        'w_out': nrm(ks[15], (DEPTH, MIX_WIDTH, D_MODEL), MIX_WIDTH ** -0.5),
        'norm_ffn_gain': 1.0 + nrm(ks[16], (DEPTH, D_MODEL), 0.02),
        'peer_w_q': nrm(ks[17], (DEPTH, D_MODEL, PEER_HEADS * PEER_QDIM), D_MODEL ** -0.5),
        'peer_keys_a': nrm(ks[18], (DEPTH, PEER_HEADS, PEER_NKEYS, PEER_QDIM // 2), (PEER_QDIM // 2) ** -0.5),
        'peer_keys_b': nrm(ks[19], (DEPTH, PEER_HEADS, PEER_NKEYS, PEER_QDIM // 2), (PEER_QDIM // 2) ** -0.5),
        'peer_u': nrm(ks[20], (DEPTH, PEER_EXPERTS, D_MODEL), D_MODEL ** -0.5),
        'peer_v': nrm(ks[21], (DEPTH, PEER_EXPERTS, D_MODEL), PEER_V_SCALE),
        'norm_final_gain': 1.0 + nrm(ks[22], (D_MODEL,), 0.02),
    }


def reference(x, norm_mix_gain, w_in, rel_bias, ssm_lambda_re, ssm_lambda_im, ssm_log_dt,
              ssm_b_re, ssm_b_im, ssm_c_re, ssm_c_im, ssm_d, ssm_w_glu, attn_out_gain,
              ssm_out_gain, w_out, norm_ffn_gain, peer_w_q, peer_keys_a, peer_keys_b,
              peer_u, peer_v, norm_final_gain):
    Bsz, S, _ = x.shape
    for l in range(DEPTH):
        h = rmsnorm(x, norm_mix_gain[l])
        proj = h @ w_in[l]
        q, k, v, u = jnp.split(proj, [ATTN_WIDTH, 2 * ATTN_WIDTH, 3 * ATTN_WIDTH], axis=-1)
        q = q.reshape(Bsz, S, ATTN_HEADS, HEAD_DIM)
        k = k.reshape(Bsz, S, ATTN_HEADS, HEAD_DIM)
        v = v.reshape(Bsz, S, ATTN_HEADS, HEAD_DIM)
        y_attn = moba_attention(q, k, v, rel_bias)
        y_ssm = s5_mixer(u, ssm_lambda_re[l], ssm_lambda_im[l], ssm_log_dt[l], ssm_b_re[l], ssm_b_im[l],
                         ssm_c_re[l], ssm_c_im[l], ssm_d[l], ssm_w_glu[l])
        y = jnp.concatenate([rmsnorm(y_attn, attn_out_gain[l]), rmsnorm(y_ssm, ssm_out_gain[l])], axis=-1)
        x = x + y @ w_out[l]
        x = x + peer_ffn(rmsnorm(x, norm_ffn_gain[l]), peer_w_q[l], peer_keys_a[l], peer_keys_b[l],
                         peer_u[l], peer_v[l])
    return rmsnorm(x, norm_final_gain)
```

```cpp
#include <hip/hip_runtime.h>
#include <cstdio>
#include <cstdint>
#define MK_N_LAUNCHES 1
#define ATTN_MFMA 1
#define TOPK_MFMA 1
#define SSM_MFMA 1
#define PROBE_MASK 0
#define P0_MASK 0
#define PROBE_GEMM 0
constexpr int BATCH = 4, SEQ = 2048, DM = 4096, T = BATCH * SEQ;
constexpr int NIN = 8192, AW = 2048, SW = 2048, NH = 16, HD = 128;
#ifndef NSPLIT_
#define NSPLIT_ 4096
#endif
constexpr int NSPLIT = NSPLIT_;
constexpr int MOBA_BLK = 256, MOBA_NB = 8;
constexpr int SG = 128, SC = 16, SP = 64;
constexpr int PH = 8, PK = 128, PQ = 256, PE = 16384, PTOP = 16, PSEL = PH * PTOP;
constexpr float RMS_EPS = 1e-6f;
constexpr float LOG2E = 1.4426950408889634f;
namespace pg8 {
#define PG8_LAS __attribute__((address_space(3)))
typedef unsigned short bf16_t;
typedef short bf16x8 __attribute__((ext_vector_type(8)));
typedef float f32x4 __attribute__((ext_vector_type(4)));
typedef unsigned u32x4 __attribute__((ext_vector_type(4)));
constexpr int BM = 256, BK = 64, HALF = 128, HTB = HALF * BK * 2  , STAGE_BYTES = 8 * HTB, NXCD = 8, WGM = 8;

__host__ __device__ __forceinline__ int lds_byte(int r, int c) { const int st = (r >> 4) * 2 + (c >> 5), rr = r & 15, cc = c & 31, ob = rr * 64 + cc * 2; return st * 1024 + (ob ^ (((ob >> 9) & 1) << 5)); }
__host__ __device__ __forceinline__ void stage_rc(int b, int& R, int& C) { const int st = b / 1024, sb = b % 1024, swz = sb ^ (((sb >> 9) & 1) << 5); R = (st >> 1) * 16 + swz / 64; C = (st & 1) * 32 + (swz % 64) / 2; }
__host__ __device__ __forceinline__ int perm32(int rho) { const int n = rho >> 4, i = rho & 15; return 8 * (i >> 2) + 4 * n + (i & 3); }

struct Unit { int pm, pn; };
struct Gemm { const bf16_t* A; const bf16_t* Bt; int M, N, K; };

struct StaticOrder {
    int nM, nN, nwg, G, c;
    __host__ __device__ void init(int M, int N, int G_, int c_) { nM = M / BM; nN = N / BM; nwg = nM * nN; G = G_; c = c_; }
    __host__ __device__ __forceinline__ bool next(int i, Unit& u) const {
        const long L = (long)i * G + c; if (L >= nwg) return false;
        int wgid = (int)L; { const int q = nwg / NXCD, r = nwg % NXCD, xcd = wgid % NXCD, off = wgid / NXCD; wgid = (xcd < r ? xcd * (q + 1) : r * (q + 1) + (xcd - r) * q) + off; }
        const int nig = WGM * nN, gid = wgid / nig, fm = gid * WGM, gsz = (nM - fm) < WGM ? (nM - fm) : WGM;
        u.pm = fm + ((wgid % nig) % gsz); u.pn = (wgid % nig) / gsz; return true;
    }
    __device__ __forceinline__ void a_ready(const Unit&) const {}
    __device__ __forceinline__ void done(const Unit&) const {}
};
struct OneOrder : StaticOrder { int only; __host__ __device__ bool next(int i, Unit& u) const { return i == 0 ? StaticOrder::next(only, u) : false; } };
__device__ __forceinline__ unsigned cvt_pk_bf16(float lo, float hi) { unsigned r; asm volatile("v_cvt_pk_bf16_f32 %0, %1, %2" : "=v"(r) : "v"(lo), "v"(hi)); return r; }
typedef float f32x2 __attribute__((ext_vector_type(2)));
__device__ __forceinline__ f32x2 gelu_pk(f32x2 v) {
    const f32x2 av = __builtin_elementwise_abs(v), d = av * 0.2316418882f + 1.0f;
    f32x2 t; t.x = __builtin_amdgcn_rcpf(d.x); t.y = __builtin_amdgcn_rcpf(d.y);
    f32x2 q = t * 0.5307027145f + (-0.7265760135f); q = q * t + 0.7107068705f; q = q * t + (-0.142248368f); q = q * t + 0.127414796f; q = q * t;
    const f32x2 s = (v * v) * (-0.72134752044f);
    f32x2 e; e.x = __builtin_amdgcn_exp2f(s.x); e.y = __builtin_amdgcn_exp2f(s.y);
    const f32x2 m = v * (q * e), r = v - m;
    f32x2 o; o.x = v.x < 0.f ? m.x : r.x; o.y = v.y < 0.f ? m.y : r.y; return o;
}
__device__ __forceinline__ float bf2f(unsigned short b) { return __uint_as_float(((unsigned)b) << 16); }
__device__ __forceinline__ float bflo(unsigned w) { return __uint_as_float(w << 16); }
__device__ __forceinline__ float bfhi(unsigned w) { return __uint_as_float(w & 0xffff0000u); }

__device__ __forceinline__ unsigned pk4_fp8(float a, float b, float c, float d) {
    int r = 0; r = __builtin_amdgcn_cvt_pk_fp8_f32(__builtin_amdgcn_fmed3f(a, -448.f, 448.f), __builtin_amdgcn_fmed3f(b, -448.f, 448.f), r, false);
    r = __builtin_amdgcn_cvt_pk_fp8_f32(__builtin_amdgcn_fmed3f(c, -448.f, 448.f), __builtin_amdgcn_fmed3f(d, -448.f, 448.f), r, true); return (unsigned)r; }
constexpr float FP8_SX1 = 8.0f, FP8_SWQ = 2048.0f;
constexpr float FP8_SYG = 8.0f, FP8_SWG = 2048.0f;
constexpr float FP8_SH = 32.0f, FP8_SWI = 2048.0f;
constexpr float FP8_SYA = 64.0f, FP8_SYS = 32.0f, FP8_SWO = 2048.0f;
struct EpiInProj {
    static constexpr bool PERM = true, AFTER_DRAIN = false;
    bf16_t* qkv; bf16_t* ub; int pn0; float sc;
    __device__ __forceinline__ void operator()(const f32x4 (&acc)[2][2][4][2], const Unit& u, int wr, int wc, int fr, int fq) const {
        const int region = (u.pn + pn0) >> 3, pnr = (u.pn + pn0) & 7;
        const int row0 = u.pm * BM + wr * 64 + fr;
#pragma unroll
        for (int ai = 0; ai < 2; ++ai)
#pragma unroll
            for (int m = 0; m < 4; ++m) {
                const int row = row0 + ai * HALF + m * 16; const int b = row >> 11, s = row & 2047;
#pragma unroll
                for (int bj = 0; bj < 2; ++bj) {
                    const int col = pnr * 256 + bj * HALF + wc * 32 + 8 * fq;
                    bf16_t* p;
                    if (region < 3) { const int h = col >> 7, d = col & 127; p = qkv + (size_t)region * ((size_t)T * 2048) + ((size_t)((b * NH + h) * SEQ + s)) * HD + d; }
                    else p = ub + ((size_t)((b * 128 + (col >> 4)) * SEQ + s)) * 16 + (col & 15);
                    const f32x4 v0 = acc[ai][bj][m][0] * sc, v1 = acc[ai][bj][m][1] * sc;
                    u32x4 w; w.x = cvt_pk_bf16(v0[0], v0[1]); w.y = cvt_pk_bf16(v0[2], v0[3]); w.z = cvt_pk_bf16(v1[0], v1[1]); w.w = cvt_pk_bf16(v1[2], v1[3]);
                    *(u32x4*)p = w;
                }
            }
    }
};
struct EpiGlu {
    static constexpr bool PERM = true, AFTER_DRAIN = false;
    const bf16_t* yg; bf16_t* ycat; float* ssq;
    __device__ __forceinline__ void piece(const f32x4 a0, const f32x4 a1, const u32x4 yv, unsigned& wx, unsigned& wy, float& ss) const {
        float y[8] = {bflo(yv.x), bfhi(yv.x), bflo(yv.y), bfhi(yv.y), bflo(yv.z), bfhi(yv.z), bflo(yv.w), bfhi(yv.w)};
        float a[8] = {a0[0], a0[1], a0[2], a0[3], a1[0], a1[1], a1[2], a1[3]};
        float o[8];
#pragma unroll
        for (int j = 0; j < 8; ++j) { const float sg = __builtin_amdgcn_rcpf(1.0f + __builtin_amdgcn_exp2f(-a[j] * (LOG2E / (FP8_SYG * FP8_SWG)))); o[j] = y[j] * sg; ss += o[j] * o[j]; }
        wx = pk4_fp8(o[0] * FP8_SYS, o[1] * FP8_SYS, o[2] * FP8_SYS, o[3] * FP8_SYS); wy = pk4_fp8(o[4] * FP8_SYS, o[5] * FP8_SYS, o[6] * FP8_SYS, o[7] * FP8_SYS);
    }
    __device__ __forceinline__ void operator()(const f32x4 (&acc)[2][2][4][2], const Unit& u, int wr, int wc, int fr, int fq) const {
        const int row0 = u.pm * BM + wr * 64 + fr;
#pragma unroll
        for (int ai = 0; ai < 2; ++ai)
#pragma unroll
            for (int mp = 0; mp < 4; mp += 2) {
                const int rowA = row0 + ai * HALF + mp * 16, rowB = rowA + 16; float ssA = 0.f, ssB = 0.f;
#pragma unroll
                for (int bj = 0; bj < 2; ++bj) {
                    const int col = u.pn * BM + bj * HALF + wc * 32 + 8 * fq;
                    const u32x4 yA = *(const u32x4*)(yg + (size_t)rowA * SW + col), yB = *(const u32x4*)(yg + (size_t)rowB * SW + col);
                    unsigned ax, ay, bx, by;
                    piece(acc[ai][bj][mp][0], acc[ai][bj][mp][1], yA, ax, ay, ssA); piece(acc[ai][bj][mp + 1][0], acc[ai][bj][mp + 1][1], yB, bx, by, ssB);
                    const auto sx = __builtin_amdgcn_permlane16_swap(ax, bx, false, false); const auto sy = __builtin_amdgcn_permlane16_swap(ay, by, false, false);
                    const u32x4 w = {sx[0], sy[0], sx[1], sy[1]};
                    const int rowS = (fq & 1) ? rowB : rowA, colS = col - 8 * (fq & 1);
                    *(u32x4*)((unsigned char*)ycat + (size_t)rowS * DM + AW + colS) = w;
                }
                ssA += __shfl_xor(ssA, 16); ssA += __shfl_xor(ssA, 32); ssB += __shfl_xor(ssB, 16); ssB += __shfl_xor(ssB, 32);
                if (fq == 0) { atomicAdd(ssq + rowA, ssA); atomicAdd(ssq + rowB, ssB); }
            }
    }
};
struct EpiOutProj {
    static constexpr bool PERM = true, AFTER_DRAIN = false;
    const float* x; bf16_t* x1bf; float* ssq; const float* ssqa; const float* ssqs; unsigned char* x1f8;
    __device__ __forceinline__ void mid(f32x4 (&acc)[2][2][4][2], const Unit& u, int wr, int fr) const {
        int row0 = u.pm * BM + wr * 64 + fr; asm volatile("" : "+v"(row0));
#pragma unroll
        for (int ai = 0; ai < 2; ++ai)
#pragma unroll
            for (int m = 0; m < 4; ++m) { const int row = row0 + ai * HALF + m * 16;
                const float ra = 1.0f / sqrtf(ssqa[row] * (1.0f / AW) + RMS_EPS), rsi = sqrtf(ssqs[row] * (1.0f / SW) + RMS_EPS); const float ratio = ra * rsi * (FP8_SYS / FP8_SYA);
#pragma unroll
                for (int bj = 0; bj < 2; ++bj)
#pragma unroll
                    for (int n = 0; n < 2; ++n) acc[ai][bj][m][n] = acc[ai][bj][m][n] * ratio; }
    }
    __device__ __forceinline__ void operator()(const f32x4 (&acc)[2][2][4][2], const Unit& u, int wr, int wc, int fr, int fq) const {
        typedef unsigned u32x2v __attribute__((ext_vector_type(2)));
        const int row0 = u.pm * BM + wr * 64 + fr, col0 = u.pn * BM + wc * 32 + 8 * fq;
#pragma unroll
        for (int ai = 0; ai < 2; ++ai)
#pragma unroll
            for (int mp = 0; mp < 4; mp += 2) {
                unsigned w8x[2][2], w8y[2][2];
#pragma unroll
                for (int mm = 0; mm < 2; ++mm) { const int m = mp + mm;
                    const int row = row0 + ai * HALF + m * 16; float ss = 0.f; const size_t off = (size_t)row * DM + col0;
                    const float rs = (1.0f / (FP8_SYS * FP8_SWO)) / sqrtf(ssqs[row] * (1.0f / SW) + RMS_EPS);
#pragma unroll
                    for (int bj = 0; bj < 2; ++bj) {
                        const f32x4 xa = *(const f32x4*)(x + off + bj * HALF), xb = *(const f32x4*)(x + off + bj * HALF + 4);
                        const f32x4 oa = xa + acc[ai][bj][m][0] * rs, ob = xb + acc[ai][bj][m][1] * rs;
                        u32x4 w; w.x = cvt_pk_bf16(oa[0], oa[1]); w.y = cvt_pk_bf16(oa[2], oa[3]); w.z = cvt_pk_bf16(ob[0], ob[1]); w.w = cvt_pk_bf16(ob[2], ob[3]);
                        *(u32x4*)(x1bf + off + bj * HALF) = w;
                        w8x[mm][bj] = pk4_fp8(oa[0] * FP8_SX1, oa[1] * FP8_SX1, oa[2] * FP8_SX1, oa[3] * FP8_SX1); w8y[mm][bj] = pk4_fp8(ob[0] * FP8_SX1, ob[1] * FP8_SX1, ob[2] * FP8_SX1, ob[3] * FP8_SX1);
                        ss += ((oa[0] * oa[0] + oa[1] * oa[1]) + (oa[2] * oa[2] + oa[3] * oa[3])) + ((ob[0] * ob[0] + ob[1] * ob[1]) + (ob[2] * ob[2] + ob[3] * ob[3]));
                    }
                    ss += __shfl_xor(ss, 16); ss += __shfl_xor(ss, 32);
                    if (fq == 0 && ssq) atomicAdd(ssq + row, ss);
                }
#pragma unroll
                for (int bj = 0; bj < 2; ++bj) {
                    const auto sx = __builtin_amdgcn_permlane16_swap(w8x[0][bj], w8x[1][bj], false, false); const auto sy = __builtin_amdgcn_permlane16_swap(w8y[0][bj], w8y[1][bj], false, false);
                    const u32x4 w = {sx[0], sy[0], sx[1], sy[1]};
                    const int rowS = row0 + ai * HALF + (mp + (fq & 1)) * 16;
                    *(u32x4*)(x1f8 + (size_t)rowS * DM + col0 - 8 * (fq & 1) + bj * HALF) = w;
                }
            }
    }
};
struct EpiPeerQ {
    static constexpr bool PERM = true, AFTER_DRAIN = false;
    const float* ssq; bf16_t* qp;
    __device__ __forceinline__ void operator()(const f32x4 (&acc)[2][2][4][2], const Unit& u, int wr, int wc, int fr, int fq) const {
        asm volatile("" : "+v"(fr), "+v"(fq));
        const int row0 = u.pm * BM + wr * 64 + fr;
#pragma unroll
        for (int ai = 0; ai < 2; ++ai)
#pragma unroll
            for (int m = 0; m < 4; ++m) {
                const int row = row0 + ai * HALF + m * 16;
                const float r = (1.0f / (FP8_SX1 * FP8_SWQ)) / sqrtf(ssq[row] * (1.0f / DM) + RMS_EPS);
#pragma unroll
                for (int bj = 0; bj < 2; ++bj) {
                    const int col = u.pn * BM + bj * HALF + wc * 32 + 8 * fq;
                    const f32x4 v0 = acc[ai][bj][m][0] * r, v1 = acc[ai][bj][m][1] * r;
                    u32x4 w; w.x = cvt_pk_bf16(v0[0], v0[1]); w.y = cvt_pk_bf16(v0[2], v0[3]); w.z = cvt_pk_bf16(v1[0], v1[1]); w.w = cvt_pk_bf16(v1[2], v1[3]);
                    *(u32x4*)(qp + (size_t)row * 2048 + col) = w;
                }
            }
    }
};
template <class Epi, class Sched, bool ALIGN_EPI = false, bool SP2 = false, bool MIDK = false, bool FP8 = false>
__device__ __forceinline__ void gemm_phase(PG8_LAS unsigned char* lds, const Gemm g, const Sched& S, const Epi& E) {
    const int tid = threadIdx.x, wid = __builtin_amdgcn_readfirstlane(tid >> 6), lane = tid & 63, wr = wid >> 2, wc = wid & 3, fr = lane & 15, fq = lane >> 4;
    const int K = FP8 ? g.K / 2 : g.K, nt = K / BK;
    unsigned voffA[2], voffB[2];
#pragma unroll
    for (int i = 0; i < 2; ++i) { int R, C; stage_rc(tid * 16 + i * 8192, R, C); const int Rb = Epi::PERM ? ((R & ~31) + perm32(R & 31)) : R;
        voffA[i] = (unsigned)(R * K + C) * 2u; voffB[i] = (unsigned)(Rb * K + C) * 2u; }
    const unsigned kstep = (unsigned)(BK * 2);
    const unsigned hstep = (unsigned)HALF * K * 2;
    const unsigned tstep = 2 * hstep;
    const unsigned ldsw = (unsigned)wid * 1024u;
    const int aoff = lds_byte(wr * 64 + fr, fq * 8), boff = lds_byte(wc * 32 + fr, fq * 8);
#define PG8_SA(b, h) (((b) * 2 + (h)) * HTB)
#define PG8_SB(b, h) ((4 + (b) * 2 + (h)) * HTB)
    const __amdgpu_buffer_rsrc_t rsA = __builtin_amdgcn_make_buffer_rsrc((void*)g.A, (short)0, (int)0x7ffff000, 0x00020000), rsB = __builtin_amdgcn_make_buffer_rsrc((void*)g.Bt, (short)0, (int)0x7ffff000, 0x00020000);
#define PG8_STAGE(bufoff, gbase, voff) do { _Pragma("unroll") for (int _i = 0; _i < 2; ++_i) \
        __builtin_amdgcn_raw_ptr_buffer_load_lds(PG8_RS_##voff, (PG8_LAS unsigned*)(lds + (bufoff) + ldsw + _i * 8192), 16, (int)(voff)[_i], (int)(gbase), 0, 0); } while (0)
#define PG8_RS_voffA rsA
#define PG8_RS_voffB rsB
#define PG8_LDA(dst, b, h) do { _Pragma("unroll") for (int m = 0; m < 4; ++m) _Pragma("unroll") for (int k = 0; k < 2; ++k) dst[m][k] = *(const PG8_LAS bf16x8*)(lds + PG8_SA(b, h) + aoff + m * 2048 + k * 1024); } while (0)
#define PG8_LDB(dst, b, h) do { _Pragma("unroll") for (int n = 0; n < 2; ++n) _Pragma("unroll") for (int k = 0; k < 2; ++k) dst[n][k] = *(const PG8_LAS bf16x8*)(lds + PG8_SB(b, h) + boff + n * 2048 + k * 1024); } while (0)
#define PG8_MMA(ai, bj, At, Bt) do { __builtin_amdgcn_s_setprio(1); _Pragma("unroll") for (int m = 0; m < 4; ++m) _Pragma("unroll") for (int n = 0; n < 2; ++n) { \
        if constexpr (FP8) { typedef int pg8_v4i __attribute__((ext_vector_type(4))); typedef int pg8_v8i __attribute__((ext_vector_type(8))); \
            const pg8_v8i bv_ = __builtin_shufflevector(__builtin_bit_cast(pg8_v4i, Bt[n][0]), __builtin_bit_cast(pg8_v4i, Bt[n][1]), 0, 1, 2, 3, 4, 5, 6, 7); \
            const pg8_v8i av_ = __builtin_shufflevector(__builtin_bit_cast(pg8_v4i, At[m][0]), __builtin_bit_cast(pg8_v4i, At[m][1]), 0, 1, 2, 3, 4, 5, 6, 7); \
              \
            asm volatile("v_mfma_scale_f32_16x16x128_f8f6f4 %0, %1, %2, %0, %3, %3 op_sel_hi:[0,0,0]" : "+v"(acc[ai][bj][m][n]) : "v"(bv_), "v"(av_), "v"(mxscale)); } \
        else { _Pragma("unroll") for (int k = 0; k < 2; ++k) acc[ai][bj][m][n] = __builtin_amdgcn_mfma_f32_16x16x32_bf16(Bt[n][k], At[m][k], acc[ai][bj][m][n], 0, 0, 0); } } \
        __builtin_amdgcn_s_setprio(0); } while (0)
#define PG8_WAIT_V(n) asm volatile("s_waitcnt vmcnt(" #n ")" ::: "memory")
#define PG8_WAIT_L(n) asm volatile("s_waitcnt lgkmcnt(" #n ")" ::: "memory")
#define PG8_BAR __builtin_amdgcn_s_barrier()
#define PG8_SCHED __builtin_amdgcn_sched_barrier(0)
    Unit cur, nxt; int ui = 0;
    if (!S.next(0, cur)) return;
    int mxscale = 0x7f7f7f7f; asm volatile("" : "+v"(mxscale));
    f32x4 acc[2][2][4][2];
#pragma unroll
    for (int a = 0; a < 2; ++a)
#pragma unroll
        for (int b = 0; b < 2; ++b)
#pragma unroll
            for (int m = 0; m < 4; ++m)
#pragma unroll
                for (int n = 0; n < 2; ++n) acc[a][b][m][n] = (f32x4){0.f, 0.f, 0.f, 0.f};
    bf16x8 At[4][2], B0[2][2], B1[2][2];
    unsigned cA = (unsigned)cur.pm * tstep, cB = (unsigned)cur.pn * tstep;
    S.a_ready(cur);
    if constexpr (SP2) {
        PG8_STAGE(PG8_SB(0, 0), cB, voffB); PG8_STAGE(PG8_SB(0, 1), cB + hstep, voffB); PG8_STAGE(PG8_SA(0, 0), cA, voffA); PG8_STAGE(PG8_SA(0, 1), cA + hstep, voffA);
        if (wr == 1) PG8_BAR;
        PG8_WAIT_V(2); PG8_BAR;
        PG8_STAGE(PG8_SB(1, 0), cB + kstep, voffB); PG8_STAGE(PG8_SA(1, 0), cA + kstep, voffA); PG8_STAGE(PG8_SB(1, 1), cB + hstep + kstep, voffB);
        PG8_WAIT_V(6); PG8_BAR;
    } else {
        PG8_STAGE(PG8_SB(0, 0), cB, voffB); PG8_STAGE(PG8_SA(0, 0), cA, voffA); PG8_STAGE(PG8_SB(0, 1), cB + hstep, voffB); PG8_STAGE(PG8_SA(0, 1), cA + hstep, voffA);
        if (wr == 1) PG8_BAR;
        PG8_WAIT_V(4); PG8_BAR;
        PG8_STAGE(PG8_SB(1, 0), cB + kstep, voffB); PG8_STAGE(PG8_SA(1, 0), cA + kstep, voffA); PG8_STAGE(PG8_SB(1, 1), cB + hstep + kstep, voffB);
        PG8_WAIT_V(6); PG8_BAR;
    }
    for (;;) {
        const bool has_next = S.next(ui + 1, nxt);
        const unsigned nA = has_next ? (unsigned)nxt.pm * tstep : cA, nB = has_next ? (unsigned)nxt.pn * tstep : cB;
        for (int t = 0; t < nt; t += 2) {
            if constexpr (MIDK) { if (t == (nt >> 1)) { if constexpr (FP8) asm volatile("s_nop 15\n\ts_nop 15" ::: "memory"); E.mid(acc, cur, wr, fr); } }
            const bool last = (t == nt - 2);
            const unsigned a1 = cA + (unsigned)(t + 1) * kstep;
            const unsigned a2 = last ? nA : cA + (unsigned)(t + 2) * kstep, b2 = last ? nB : cB + (unsigned)(t + 2) * kstep;
            const unsigned a3 = a2 + kstep, b3 = b2 + kstep;
            if (last && has_next) S.a_ready(nxt);
            if constexpr (SP2) {
            PG8_LDB(B0, 0, 0); PG8_LDB(B1, 0, 1); PG8_SCHED; PG8_LDA(At, 0, 0); PG8_STAGE(PG8_SA(1, 1), a1 + hstep, voffA);
            PG8_WAIT_V(8); PG8_WAIT_L(0); PG8_BAR; PG8_MMA(0, 0, At, B0); PG8_MMA(0, 1, At, B1); PG8_BAR; PG8_SCHED;
            PG8_LDA(At, 0, 1); PG8_STAGE(PG8_SB(0, 0), b2, voffB); PG8_STAGE(PG8_SB(0, 1), b2 + hstep, voffB); PG8_STAGE(PG8_SA(0, 0), a2, voffA);
            PG8_WAIT_V(8); PG8_WAIT_L(0); PG8_BAR; PG8_MMA(1, 0, At, B0); PG8_MMA(1, 1, At, B1); PG8_BAR; PG8_SCHED;
            PG8_LDB(B0, 1, 0); PG8_LDB(B1, 1, 1); PG8_SCHED; PG8_LDA(At, 1, 0); PG8_STAGE(PG8_SA(0, 1), a2 + hstep, voffA);
            PG8_WAIT_V(8); PG8_WAIT_L(0); PG8_BAR; PG8_MMA(0, 0, At, B0); PG8_MMA(0, 1, At, B1); PG8_BAR; PG8_SCHED;
            PG8_LDA(At, 1, 1); PG8_STAGE(PG8_SB(1, 0), b3, voffB); PG8_STAGE(PG8_SB(1, 1), b3 + hstep, voffB); PG8_STAGE(PG8_SA(1, 0), a3, voffA);
            PG8_WAIT_V(8); PG8_WAIT_L(0); PG8_BAR; PG8_MMA(1, 0, At, B0); PG8_MMA(1, 1, At, B1); PG8_BAR; PG8_SCHED;
            } else {
            PG8_LDB(B0, 0, 0); PG8_SCHED; PG8_LDA(At, 0, 0); PG8_STAGE(PG8_SA(1, 1), a1 + hstep, voffA);
            PG8_WAIT_L(8); PG8_BAR; PG8_WAIT_L(0); PG8_MMA(0, 0, At, B0); PG8_BAR; PG8_SCHED;
            PG8_LDB(B1, 0, 1); PG8_STAGE(PG8_SB(0, 0), b2, voffB);
            PG8_BAR; PG8_WAIT_L(0); PG8_MMA(0, 1, At, B1); PG8_BAR;
            PG8_LDA(At, 0, 1); PG8_STAGE(PG8_SA(0, 0), a2, voffA);
            PG8_BAR; PG8_WAIT_L(0); PG8_MMA(1, 0, At, B0); PG8_BAR; PG8_SCHED;
            PG8_STAGE(PG8_SB(0, 1), b2 + hstep, voffB);
            PG8_WAIT_V(6); PG8_BAR; PG8_MMA(1, 1, At, B1); PG8_BAR;
            PG8_LDB(B0, 1, 0); PG8_SCHED; PG8_LDA(At, 1, 0); PG8_STAGE(PG8_SA(0, 1), a2 + hstep, voffA);
            PG8_WAIT_L(8); PG8_BAR; PG8_WAIT_L(0); PG8_MMA(0, 0, At, B0); PG8_BAR; PG8_SCHED;
            PG8_LDB(B1, 1, 1); PG8_STAGE(PG8_SB(1, 0), b3, voffB);
            PG8_BAR; PG8_WAIT_L(0); PG8_MMA(0, 1, At, B1); PG8_BAR;
            PG8_LDA(At, 1, 1); PG8_STAGE(PG8_SA(1, 0), a3, voffA);
            PG8_BAR; PG8_WAIT_L(0); PG8_MMA(1, 0, At, B0); PG8_BAR; PG8_SCHED;
            PG8_STAGE(PG8_SB(1, 1), b3 + hstep, voffB);
            PG8_WAIT_V(6); PG8_BAR; PG8_MMA(1, 1, At, B1); PG8_BAR;
            }
        }
        if constexpr (FP8) asm volatile("s_nop 15\n\ts_nop 15" ::: "memory");
        if constexpr (ALIGN_EPI) { if (wr == 0) PG8_BAR; }
        if constexpr (!Epi::AFTER_DRAIN) { E(acc, cur, wr, wc, fr, fq); S.done(cur); }
        if (!has_next) break;
#pragma unroll
        for (int a = 0; a < 2; ++a)
#pragma unroll
            for (int b = 0; b < 2; ++b)
#pragma unroll
                for (int m = 0; m < 4; ++m)
#pragma unroll
                    for (int n = 0; n < 2; ++n) acc[a][b][m][n] = (f32x4){0.f, 0.f, 0.f, 0.f};
        cur = nxt; cA = nA; cB = nB; ++ui;
        if constexpr (ALIGN_EPI) { if (wr == 1) PG8_BAR; }
    }
    PG8_WAIT_V(0);
    if constexpr (!ALIGN_EPI) { if (wr == 0) PG8_BAR; }
    PG8_BAR;
    if constexpr (Epi::AFTER_DRAIN) { E.fused(acc, cur, wr, wc, fr, fq, lds, wid, lane); S.done(cur); }
#undef PG8_SA
#undef PG8_SB
#undef PG8_STAGE
#undef PG8_RS_voffA
#undef PG8_RS_voffB
#undef PG8_LDA
#undef PG8_LDB
#undef PG8_MMA
#undef PG8_WAIT_V
#undef PG8_WAIT_L
#undef PG8_BAR
#undef PG8_SCHED
}
}
constexpr int NWAVES = 8;
constexpr size_t MiB = 1u << 20;
constexpr size_t WS_CTL = 0, CTL_ZERO_BYTES = 1 * MiB;
constexpr size_t WS_WIN = 2 * MiB;
constexpr size_t WS_WGLU = 66 * MiB;
constexpr size_t WS_WOUT = 74 * MiB;
constexpr size_t WS_WQ = 106 * MiB;
constexpr size_t WS_KEYS = 122 * MiB;
constexpr size_t WS_KMEAN = 123 * MiB;
constexpr size_t WS_BLUT = 123 * MiB + 512 * 1024;
constexpr size_t WS_SU = 123 * MiB + 768 * 1024;
constexpr size_t WS_SV = 123 * MiB + 896 * 1024;
constexpr size_t WS_SKERN = 124 * MiB;
constexpr size_t WS_SW = 130 * MiB;
constexpr size_t WS_SVM = 162 * MiB;
constexpr size_t WS_H = 194 * MiB;
constexpr size_t WS_QKV = 258 * MiB;
constexpr size_t WS_U = 354 * MiB;
constexpr size_t WS_YG = 386 * MiB;
constexpr size_t WS_YCAT = 418 * MiB;
constexpr size_t WS_X1 = 482 * MiB;
constexpr size_t WS_X1BF = 610 * MiB;
constexpr size_t WS_QP = 674 * MiB;
constexpr size_t WS_EXP = 706 * MiB;
constexpr size_t WS_GATE = 710 * MiB;
constexpr size_t WS_U8 = 714 * MiB;
constexpr size_t WS_V8 = 778 * MiB;
constexpr size_t WS_END = 842 * MiB;
constexpr size_t WS_XH = WS_H, WS_XL = WS_H + 16 * MiB, WS_XS = WS_H + 32 * MiB;
constexpr size_t WS_X1F8 = WS_YG;
constexpr size_t WS_X2B = WS_YCAT;
constexpr size_t WS_CB = WS_X1, WS_TS = WS_X1 + 4 * MiB;
constexpr size_t WS_WIN8 = WS_WIN + 48 * MiB;
constexpr size_t WS_H8 = WS_X1 + 16 * MiB;
constexpr size_t WS_YG8 = WS_X1 + 64 * MiB;
constexpr size_t WS_PART = WS_QKV;
constexpr int CW_BAR = 4096;
constexpr int CW_SSQA = 65536, CW_SSQS = CW_SSQA + T, CW_SSQ1 = CW_SSQS + T;
constexpr int CW_SSQAT = CW_SSQ1 + T;
static_assert((CW_SSQAT + T) * 4 <= (int)CTL_ZERO_BYTES, "ctl");
constexpr int RING_OFF = 0, RING_BYTES = 131072;
constexpr int LDSCTL_OFF = RING_BYTES, MISC_OFF = LDSCTL_OFF + 320;
constexpr int LDS_BYTES = 147456;

#define GAS __attribute__((address_space(1)))
#define LAS __attribute__((address_space(3)))
typedef unsigned short bf16;
typedef unsigned v4u __attribute__((ext_vector_type(4)));
typedef unsigned v2u __attribute__((ext_vector_type(2)));
typedef float f32x4 __attribute__((ext_vector_type(4)));
typedef float f32x2 __attribute__((ext_vector_type(2)));
typedef GAS unsigned gu32;
#define LDS_WAIT() asm volatile("s_waitcnt lgkmcnt(0)" ::: "memory")
#define VM_WAIT() asm volatile("s_waitcnt vmcnt(0)" ::: "memory")
__device__ __forceinline__ unsigned pk2(float lo, float hi) { unsigned r; asm("v_cvt_pk_bf16_f32 %0, %1, %2" : "=v"(r) : "v"(lo), "v"(hi)); return r; }
__device__ __forceinline__ unsigned f2bf(float f) { return pk2(f, 0.f) & 0xffffu; }
__device__ __forceinline__ float bf2f(unsigned short b) { return __uint_as_float(((unsigned)b) << 16); }
__device__ __forceinline__ float bflo(unsigned w) { return __uint_as_float(w << 16); }
__device__ __forceinline__ float bfhi(unsigned w) { return __uint_as_float(w & 0xffff0000u); }
__device__ __forceinline__ float wave_sum(float v) {
#pragma unroll
    for (int o = 1; o < 64; o <<= 1) v += __shfl_xor(v, o);
    return v;
}
__device__ __forceinline__ float wave_max(float v) {
#pragma unroll
    for (int o = 1; o < 64; o <<= 1) v = fmaxf(v, __shfl_xor(v, o));
    return v;
}
__device__ __forceinline__ float gelu_erf(float v) { return 0.5f * v * (1.0f + erff(v * 0.70710678118654752f)); }
#define XB_TMO      128
#define XB_XCNT(j)  (256  + 64 * (j))
#define XB_XSUB(j)  (1280 + 64 * (j))
#define XB_XGEN(j)  (2304 + 64 * (j))
#define XB_TOP      3328
#define XB_TOPGEN   3392
#define XCD_BAR_WORDS 3456
#define XB_SPIN_CAP (1u << 18)

__device__ __forceinline__ unsigned xb_ld(unsigned* p)              { return __hip_atomic_load(p, __ATOMIC_RELAXED, __HIP_MEMORY_SCOPE_AGENT); }
__device__ __forceinline__ unsigned xb_add(unsigned* p, unsigned v) { return __hip_atomic_fetch_add(p, v, __ATOMIC_RELAXED, __HIP_MEMORY_SCOPE_AGENT); }
__device__ __forceinline__ unsigned xb_xcc_id() { return (unsigned)__builtin_amdgcn_s_getreg((3 << 11) | 20) & 0xFu; }
#define XB_SPIN(cond, bar) do { unsigned _sp = 0; while (cond) { __builtin_amdgcn_s_sleep(1); \
    if ((++_sp & 255u) == 0u) { if (xb_ld(&(bar)[XB_TMO])) break; if (_sp > XB_SPIN_CAP) { atomicAdd(&(bar)[XB_TMO], 1u); break; } } } } while (0)

struct XcdBarrier {
    unsigned* bar; unsigned x;
    volatile LAS unsigned* st;
};

__device__ __forceinline__ XcdBarrier xcd_barrier_post(unsigned* bar, volatile LAS unsigned* st) {
    XcdBarrier b; b.bar = bar; b.x = xb_xcc_id(); b.st = st;
    if (threadIdx.x == 0) (void)xb_add(&bar[XB_XCNT(b.x)], 1u);
    return b;
}
__device__ __forceinline__ void xcd_barrier_complete(unsigned* bar, unsigned x, unsigned& nloc, unsigned& nx) {
    const unsigned G = gridDim.x * gridDim.y * gridDim.z;
    unsigned sum, cnt, mine, sp = 0u;
    for (;;) {
        sum = 0u; cnt = 0u; mine = 0u;
#pragma unroll
        for (unsigned j = 0; j < 16; ++j) { const unsigned c = xb_ld(&bar[XB_XCNT(j)]); sum += c; cnt += (c > 0u) ? 1u : 0u; mine = (j == x) ? c : mine; }
        if (sum == G) break;
        __builtin_amdgcn_s_sleep(1);
        if ((++sp & 255u) == 0u) { if (xb_ld(&bar[XB_TMO])) break; if (sp > XB_SPIN_CAP) { atomicAdd(&bar[XB_TMO], 1u); break; } }
    }
    nloc = mine > 0u ? mine : 1u; nx = cnt > 0u ? cnt : 1u;
}

__device__ __forceinline__ void xcd_barrier(const XcdBarrier& b) {
    asm volatile("s_waitcnt vmcnt(0)" ::: "memory");
    __syncthreads();
    if (threadIdx.x == 0) {
        unsigned* bar = b.bar;
        __builtin_amdgcn_s_waitcnt(0);
        unsigned nloc = b.st[0], nx = b.st[1];
        if (nloc == 0u) { xcd_barrier_complete(bar, b.x, nloc, nx); b.st[0] = nloc; b.st[1] = nx; }
        const unsigned old = xb_add(&bar[XB_XSUB(b.x)], 1u);
        const unsigned gen = old / nloc;
        if (old + 1u == (gen + 1u) * nloc) {
            __builtin_amdgcn_fence(__ATOMIC_RELEASE, "agent");
            asm volatile("s_waitcnt vmcnt(0)" ::: "memory");
            const unsigned og = xb_add(&bar[XB_TOP], 1u);
            const unsigned tg = og / nx;
            if (og + 1u == (tg + 1u) * nx) xb_add(&bar[XB_TOPGEN], 1u);
            else XB_SPIN(xb_ld(&bar[XB_TOPGEN]) == tg, bar);
            __builtin_amdgcn_fence(__ATOMIC_ACQUIRE, "agent");
            xb_add(&bar[XB_XGEN(b.x)], 1u);
            asm volatile("s_waitcnt vmcnt(0)" ::: "memory");
        } else {
            XB_SPIN(xb_ld(&bar[XB_XGEN(b.x)]) == gen, bar);
            __builtin_amdgcn_fence(__ATOMIC_ACQUIRE, "agent");
            asm volatile("s_waitcnt vmcnt(0)" ::: "memory");
        }
    }
    __syncthreads();
}
namespace att {
#define ALAS __attribute__((address_space(3)))
typedef unsigned short bf16;
typedef short bf16x8 __attribute__((ext_vector_type(8)));
typedef short s16x4 __attribute__((ext_vector_type(4)));
typedef float f32x16 __attribute__((ext_vector_type(16)));
typedef float f32x4 __attribute__((ext_vector_type(4)));
typedef unsigned u32x4 __attribute__((ext_vector_type(4)));
template <class A, class Bt> struct same_t { static constexpr bool v = false; };
template <class A> struct same_t<A, A> { static constexpr bool v = true; };
constexpr int D = 128;
constexpr float THR = 8.f;
constexpr float SCALE = 0.08838834764831845f;
constexpr int NW = 8, QBLK = 32, KVBLK = 64, QB = NW * QBLK;
constexpr int SHM_V = KVBLK * D * 2, SHM_K = KVBLK * D * 2;
#define KSWZ(row, colB) ((row) * 256 + ((colB) ^ (((row) & 7) << 4)))
#define SBAR() __builtin_amdgcn_sched_barrier(0)
__device__ __forceinline__ int v_st(int k, int c) { const int kk = (k & ~0xC) | ((k & 4) << 1) | ((k & 8) >> 1); return ((kk >> 3) * 4 + (c >> 5)) * 512 + ((kk & 7) * 32 + (c & 31)) * 2; }
__device__ __forceinline__ int v_rd_base(int lane) { return ((lane & 3) << 3) | (((lane >> 2) & 3) << 6) | (((lane >> 4) & 1) << 5) | (((lane >> 5) & 1) << 8); }
constexpr int v_rd_off(int d0, int ks, int half) { return d0 * 512 + ks * 4096 + half * 2048; }
__device__ __forceinline__ int crow(int r, int hi) { return (r & 3) + 8 * (r >> 2) + 4 * hi; }
__device__ __forceinline__ unsigned cvtpk(float lo, float hi) {
    unsigned r; asm volatile("v_cvt_pk_bf16_f32 %0, %1, %2" : "=v"(r) : "v"(lo), "v"(hi)); return r;
}
__device__ __forceinline__ bf16x8 pack8(f32x4 a, f32x4 b) {
    u32x4 w = {cvtpk(a[0], a[1]), cvtpk(a[2], a[3]), cvtpk(b[0], b[1]), cvtpk(b[2], b[3])};
    return *reinterpret_cast<bf16x8*>(&w);
}
template <class T> __device__ __forceinline__ bf16x8 load8(const T* p) {
    if constexpr (same_t<T, float>::v) { return pack8(*(const f32x4*)p, *(const f32x4*)(p + 4)); }
    else { return *reinterpret_cast<const bf16x8*>(p); }
}
__device__ __forceinline__ void mask_tile(f32x16& p0, f32x16& p1, int dq, unsigned W) {
    const float NEG = -__builtin_inff();
#pragma unroll
    for (int r = 0; r < 16; ++r) {
        const int c = (r & 3) + 8 * (r >> 2);
        if ((unsigned)(dq - c) >= W) p0[r] = NEG;
        if ((unsigned)(dq - c - 32) >= W) p1[r] = NEG;
    }
}
__device__ __forceinline__ void partialSM(f32x16& p0, f32x16& p1, float& m_reg, float& mn, float& alpha) {
    float pmax = p0[0]; for (int r = 1; r < 16; ++r) pmax = fmaxf(pmax, p0[r]); for (int r = 0; r < 16; ++r) pmax = fmaxf(pmax, p1[r]);
    { auto rr = __builtin_amdgcn_permlane32_swap(__float_as_uint(pmax), __float_as_uint(pmax), false, false);
      pmax = fmaxf(__uint_as_float(rr[0]), __uint_as_float(rr[1])); }
    constexpr float C2 = 1.4426950408889634f * SCALE;
    if (__builtin_expect(__all((pmax - m_reg) * SCALE <= THR), 1)) { mn = m_reg; alpha = 1.f; }
    else { mn = fmaxf(m_reg, pmax); alpha = __builtin_amdgcn_exp2f((m_reg - mn) * C2); m_reg = mn; }
    const float mnL = -mn * C2;
    for (int r = 0; r < 16; ++r) p0[r] = fmaf(p0[r], C2, mnL); for (int r = 0; r < 16; ++r) p1[r] = fmaf(p1[r], C2, mnL);
    for (int r = 0; r < 16; ++r) p0[r] = __builtin_amdgcn_exp2f(p0[r]);
}
__device__ __forceinline__ void finishSM(f32x16& p0, f32x16& p1, float alpha, float& l_reg, bf16x8& pa0, bf16x8& pa1, bf16x8& pa2, bf16x8& pa3) {
    for (int r = 0; r < 16; ++r) p1[r] = __builtin_amdgcn_exp2f(p1[r]);
    float ps = 0; for (int r = 0; r < 16; ++r) ps += p0[r]; for (int r = 0; r < 16; ++r) ps += p1[r];
    { auto rr = __builtin_amdgcn_permlane32_swap(__float_as_uint(ps), __float_as_uint(ps), false, false);
      ps = __uint_as_float(rr[0]) + __uint_as_float(rr[1]); }
    l_reg = l_reg * alpha + ps;
#define PK4(P, B_, OUT) do { unsigned a0 = cvtpk(P[B_+0], P[B_+1]), a1 = cvtpk(P[B_+2], P[B_+3]);                          \
        unsigned b0 = cvtpk(P[B_+4], P[B_+5]), b1 = cvtpk(P[B_+6], P[B_+7]);                                             \
        auto r0 = __builtin_amdgcn_permlane32_swap(a0, b0, false, false); auto r1 = __builtin_amdgcn_permlane32_swap(a1, b1, false, false); \
        u32x4 w = {r0[0], r1[0], r0[1], r1[1]}; OUT = *reinterpret_cast<bf16x8*>(&w); } while (0)
    PK4(p0, 0, pa0); PK4(p0, 8, pa1); PK4(p1, 0, pa2); PK4(p1, 8, pa3);
#undef PK4
}
template <int KB, bool SK>
__device__ __forceinline__ void qkt(f32x16& p0, f32x16& p1, const char* K_lds, int r32, int hi, const bf16x8* qr, bool act) {
    if (SK && !act) { const float NEG = -__builtin_inff();
#pragma unroll
        for (int r = 0; r < 16; ++r) { p0[r] = NEG; p1[r] = NEG; } return; }
    p0 = f32x16{}; p1 = f32x16{};
    const char* kb[4];
#pragma unroll
    for (int dd = 0; dd < 4; ++dd) kb[dd] = K_lds + KB * SHM_K + KSWZ(r32, (dd * 16 + hi * 8) * 2);
#pragma unroll
    for (int d0 = 0; d0 < 8; ++d0) { const char* a = kb[d0 & 3] + (d0 >> 2) * 128;
        bf16x8 b0 = *reinterpret_cast<const bf16x8*>(a);
        bf16x8 b1 = *reinterpret_cast<const bf16x8*>(a + 32 * 256);
        p0 = __builtin_amdgcn_mfma_f32_32x32x16_bf16(b0, qr[d0], p0, 0, 0, 0);
        p1 = __builtin_amdgcn_mfma_f32_32x32x16_bf16(b1, qr[d0], p1, 0, 0, 0); }
}
template <int VB, bool SK>
__device__ __forceinline__ void pv_tile(f32x16* o, int vb0, bf16x8 pa0, bf16x8 pa1, bf16x8 pa2, bf16x8 pa3, bool act) {
    if (SK && !act) return;
#define TRRD(dst, off) asm volatile("ds_read_b64_tr_b16 %0, %1 offset:%2" : "=&v"(dst) : "v"(vb0), "i"(off) : "memory")
#define PV_D0(d0) do { s16x4 l0, l1, l2, l3, h0, h1, h2, h3; constexpr int b_ = VB * SHM_V + v_rd_off(d0, 0, 0);     \
        TRRD(l0, b_); TRRD(h0, b_ + 2048); TRRD(l1, b_ + 4096); TRRD(h1, b_ + 6144); TRRD(l2, b_ + 8192); TRRD(h2, b_ + 10240); TRRD(l3, b_ + 12288); TRRD(h3, b_ + 14336); \
        asm volatile("s_waitcnt lgkmcnt(0)" ::: "memory"); SBAR();                 \
        o[d0] = __builtin_amdgcn_mfma_f32_32x32x16_bf16(pa0, (bf16x8){l0[0], l0[1], l0[2], l0[3], h0[0], h0[1], h0[2], h0[3]}, o[d0], 0, 0, 0);   \
        o[d0] = __builtin_amdgcn_mfma_f32_32x32x16_bf16(pa1, (bf16x8){l1[0], l1[1], l1[2], l1[3], h1[0], h1[1], h1[2], h1[3]}, o[d0], 0, 0, 0);   \
        o[d0] = __builtin_amdgcn_mfma_f32_32x32x16_bf16(pa2, (bf16x8){l2[0], l2[1], l2[2], l2[3], h2[0], h2[1], h2[2], h2[3]}, o[d0], 0, 0, 0);   \
        o[d0] = __builtin_amdgcn_mfma_f32_32x32x16_bf16(pa3, (bf16x8){l3[0], l3[1], l3[2], l3[3], h3[0], h3[1], h3[2], h3[3]}, o[d0], 0, 0, 0); } while (0)
    PV_D0(0); PV_D0(1); PV_D0(2); PV_D0(3);
#undef PV_D0
#undef TRRD
}
constexpr int ATT_KM_OFF = 2 * SHM_V + 2 * SHM_K + NW * 64 * 4, ATT_LUT_OFF = ATT_KM_OFF + 4096, ATT_LUT_N = 640, ATT_LDS_BYTES = ATT_LUT_OFF + ATT_LUT_N * 4;
constexpr int OSTR = 4096;
constexpr float OSCALE = 64.0f;
struct BlockRef { const bf16* Q; const bf16* K; const bf16* V; bf16* O; const float* KM; const float* BL; float* SSQ; int P0; };
struct Seam { bf16x8 qr[8]; bf16x8 st_v0, st_v1, st_k0, st_k1; };
#define ROW(p, k0, rr) ((p) + (size_t)((k0) + (rr)) * D + sc)
#define VMW() asm volatile("s_waitcnt vmcnt(0)" ::: "memory")
#define VMWN(n) asm volatile("s_waitcnt vmcnt(%0)" :: "i"(n) : "memory")
#define SLOAD_H(Kp, Vp, k0) do { S.st_v0 = load8<bf16>(ROW(Vp, k0, sr)); S.st_v1 = load8<bf16>(ROW(Vp, k0, 32 + sr));              \
                         S.st_k0 = load8<bf16>(ROW(Kp, k0, sr)); S.st_k1 = load8<bf16>(ROW(Kp, k0, 32 + sr)); } while (0)
#define SWRITE_HK(bf) do { *(bf16x8*)(K_lds + (bf) * SHM_K + kws) = S.st_k0; *(bf16x8*)(K_lds + (bf) * SHM_K + kws + 32 * 256) = S.st_k1; } while (0)
#define SWRITE_HV(bf) do { *(bf16x8*)(V_lds + (bf) * SHM_V + vst0) = S.st_v0; *(bf16x8*)(V_lds + (bf) * SHM_V + vst1) = S.st_v1; } while (0)
#define SWRITE_H(bf) do { SWRITE_HV(bf); SWRITE_HK(bf); } while (0)
__device__ __forceinline__ void moba_prime(const BlockRef& cur, char* lds, Seam& S) {
    const int tid = threadIdx.x, wid = __builtin_amdgcn_readfirstlane(tid >> 6), lane = tid & 63, r32 = lane & 31, hi = lane >> 5;
    const int sr = tid >> 4, sc = (tid & 15) * 8, kws = KSWZ(sr, sc * 2); char* K_lds = lds + 2 * SHM_V;
    for (int d0 = 0; d0 < 8; ++d0) S.qr[d0] = load8<bf16>(cur.Q + (size_t)(wid * QBLK + r32) * D + d0 * 16 + hi * 8);
    SLOAD_H(cur.K, cur.V, 0); VMW(); SWRITE_HK(0);
    __syncthreads();
}
__device__ __forceinline__ void add_tile(f32x16& p0, f32x16& p1, float a) {
#pragma unroll
    for (int r = 0; r < 16; ++r) { p0[r] += a; p1[r] += a; }
}
__device__ __forceinline__ void bias_tile(f32x16& p0, f32x16& p1, const ALAS float* lutp, float a) {
#pragma unroll
    for (int r = 0; r < 16; ++r) { const int c = (r & 3) + 8 * (r >> 2); p0[r] += lutp[c] + a; p1[r] += lutp[c + 32] + a; }
}
__device__ __forceinline__ void moba_block(const BlockRef& cur, const BlockRef& nxt, char* lds, ALAS unsigned char* ldsl, Seam& S) {
    int lane; asm volatile("v_mbcnt_lo_u32_b32 %0, -1, 0\n\tv_mbcnt_hi_u32_b32 %0, -1, %0" : "=v"(lane));
    const int wid = __builtin_amdgcn_readfirstlane(threadIdx.x >> 6), tid = wid * 64 + lane, r32 = lane & 31, hi = lane >> 5;
    const int NT = cur.P0 / KVBLK + 4;
    const int qblk = cur.P0 >> 8;
    const int qlo = cur.P0 + wid * QBLK, qm = qlo + r32 - 4 * hi;
    char* V_lds = lds; char* K_lds = lds + 2 * SHM_V;
    float* ws = (float*)(lds + 2 * SHM_V + 2 * SHM_K) + wid * 64; float* li_l = ws, * al_l = ws + 32;
    ALAS float* km_l = (ALAS float*)(ldsl + ATT_KM_OFF); ALAS float* lut_l = (ALAS float*)(ldsl + ATT_LUT_OFF);
    float m_reg = -1e30f, l_reg = 0; f32x16 o[4] = {};
    const int sr = tid >> 4, sc = (tid & 15) * 8, vst0 = v_st(sr, sc), vst1 = v_st(32 + sr, sc), kws = KSWZ(sr, sc * 2);
    const int vb0 = (int)(uintptr_t)V_lds + v_rd_base(lane);
    const bf16* Kh = cur.K; const bf16* Vh = cur.V;
    { const int tq = tid;
      if (tq < 256) *(ALAS f32x4*)(km_l + tq * 4) = *(const f32x4*)(cur.KM + tq * 4);
      for (int y = tq; y < ATT_LUT_N; y += 512) { int dist = 255 - y; dist = dist < 0 ? 0 : (dist > 127 ? 127 : dist); lut_l[y] = cur.BL[dist] * (1.0f / SCALE); } }
    const float b31 = cur.BL[127] * (1.0f / SCALE);
    __syncthreads();
    unsigned selmask = 0u;
    if (qblk > 0) {
        float gate[7];
#pragma unroll
        for (int j = 0; j < 7; ++j) {
            float g = 0.f;
            if (j < qblk) {
#pragma unroll
                for (int d0 = 0; d0 < 8; ++d0) { const f32x4 k0 = *(const ALAS f32x4*)(km_l + j * 128 + d0 * 16 + hi * 8), k1 = *(const ALAS f32x4*)(km_l + j * 128 + d0 * 16 + hi * 8 + 4);
                    const bf16x8 qv = S.qr[d0];
                    g += __uint_as_float(((unsigned)(unsigned short)qv[0]) << 16) * k0[0] + __uint_as_float(((unsigned)(unsigned short)qv[1]) << 16) * k0[1]
                       + __uint_as_float(((unsigned)(unsigned short)qv[2]) << 16) * k0[2] + __uint_as_float(((unsigned)(unsigned short)qv[3]) << 16) * k0[3]
                       + __uint_as_float(((unsigned)(unsigned short)qv[4]) << 16) * k1[0] + __uint_as_float(((unsigned)(unsigned short)qv[5]) << 16) * k1[1]
                       + __uint_as_float(((unsigned)(unsigned short)qv[6]) << 16) * k1[2] + __uint_as_float(((unsigned)(unsigned short)qv[7]) << 16) * k1[3]; }
                auto rr = __builtin_amdgcn_permlane32_swap(__float_as_uint(g), __float_as_uint(g), false, false);
                g = __uint_as_float(rr[0]) + __uint_as_float(rr[1]);
            }
            gate[j] = g;
        }
#pragma unroll
        for (int r = 0; r < 3; ++r) { if (r < qblk) { float best = 0.f; int bi = -1;
#pragma unroll
                for (int j = 0; j < 7; ++j) { if (j < qblk && !((selmask >> j) & 1u) && (bi < 0 || gate[j] > best)) { best = gate[j]; bi = j; } }
                selmask |= 1u << bi; } }
    }
#define RESC(a) do { if (__any((a) < 1.f)) { if (hi == 0) al_l[r32] = (a); asm volatile("s_waitcnt lgkmcnt(0)" ::: "memory");              \
                     for (int d_ = 0; d_ < 4; ++d_) for (int r = 0; r < 16; ++r) o[d_][r] *= al_l[crow(r, hi)]; } } while (0)
#define KBASE(t) ((t) * KVBLK)
#define MASKT(P0_, P1_, t) do { const int kb_ = KBASE(t); const int jb_ = kb_ >> 8; const bool near_ = (qlo - (kb_ + KVBLK - 1)) < 113;                              \
        const float sel_ = (jb_ == qblk || ((selmask >> jb_) & 1u)) ? 0.f : -__builtin_inff();                                                                     \
        if (near_) { int dq_ = qm - kb_; dq_ = dq_ < -260 ? -260 : dq_; bias_tile(P0_, P1_, lut_l + (255 - dq_), sel_); }              \
        else add_tile(P0_, P1_, sel_ + b31);                                                                                                                       \
        if (kb_ + KVBLK - 1 > qlo) mask_tile(P0_, P1_, qm - kb_, 0x7fffffffu); } while (0)
    constexpr int NQL = 8; constexpr bool SK = false;
#define SEAM_K0() do { VMWN(NQL); SWRITE_HK(0); SBAR(); } while (0)
    f32x16 pA0, pA1, pB0, pB1; float mnA, mnB, alA, alB; bf16x8 pa0, pa1, pa2, pa3;
    SWRITE_HV(0); SBAR();
    SLOAD_H(Kh, Vh, KBASE(1));
    SBAR(); qkt<0, SK>(pA0, pA1, K_lds, r32, hi, S.qr, true);
    MASKT(pA0, pA1, 0); partialSM(pA0, pA1, m_reg, mnA, alA);
    VMW(); SWRITE_H(1);
    __syncthreads();
#define HALF_STEP(PX0, PX1, mnX, alX, PY0, PY1, alY, t, KB, VB, SB) do {                                                      \
        SBAR(); qkt<KB, SK>(PX0, PX1, K_lds, r32, hi, S.qr, true);                                                            \
        finishSM(PY0, PY1, alY, l_reg, pa0, pa1, pa2, pa3); SBAR();                                                           \
        if ((t) + 1 < NT) { SLOAD_H(Kh, Vh, KBASE((t) + 1)); SBAR(); }                                                        \
        pv_tile<VB, SK>(o, vb0, pa0, pa1, pa2, pa3, true); MASKT(PX0, PX1, (t)); partialSM(PX0, PX1, m_reg, mnX, alX);        \
        __syncthreads();                                                                                                      \
        if ((t) + 1 < NT) { VMW(); SWRITE_H(SB); }                                                                            \
        RESC(alX); __syncthreads(); } while (0)
    for (int t = 1; t + 1 < NT; t += 2) {
        HALF_STEP(pB0, pB1, mnB, alB, pA0, pA1, alA, t, 1, 0, 0);
        HALF_STEP(pA0, pA1, mnA, alA, pB0, pB1, alB, t + 1, 0, 1, 1);
    }
    SBAR(); qkt<1, SK>(pB0, pB1, K_lds, r32, hi, S.qr, true); SBAR();
    SLOAD_H(nxt.K, nxt.V, 0); SBAR();
#pragma unroll
    for (int d0 = 0; d0 < 8; ++d0) S.qr[d0] = load8<bf16>(nxt.Q + (size_t)(wid * QBLK + r32) * D + d0 * 16 + hi * 8);
    SBAR();
    finishSM(pA0, pA1, alA, l_reg, pa0, pa1, pa2, pa3); SBAR();
    pv_tile<0, SK>(o, vb0, pa0, pa1, pa2, pa3, true);
    MASKT(pB0, pB1, NT - 1); partialSM(pB0, pB1, m_reg, mnB, alB); __syncthreads(); RESC(alB);
    finishSM(pB0, pB1, alB, l_reg, pa0, pa1, pa2, pa3); SBAR(); pv_tile<1, SK>(o, vb0, pa0, pa1, pa2, pa3, true);
    SBAR(); SEAM_K0();
    if (hi == 0) li_l[r32] = l_reg; asm volatile("s_waitcnt lgkmcnt(0)" ::: "memory");
    float rli[16];
#pragma unroll
    for (int r = 0; r < 16; ++r) rli[r] = __builtin_amdgcn_rcpf(li_l[crow(r, hi)]);
    {
        const __amdgpu_buffer_rsrc_t rO = __builtin_amdgcn_make_buffer_rsrc((void*)((unsigned char*)cur.O + (size_t)(wid * QBLK) * OSTR), (short)0, (int)(QBLK * OSTR), 0x00020000);
        const int voff = 4 * hi * OSTR + (r32 & 3) * 32 + (r32 & 28);
        const unsigned qi = (unsigned)(r32 & 3);
        const unsigned selA = qi | ((4u + qi) << 8) | 0x0c0c0000u, selB = 0x00000c0cu | (qi << 16) | ((4u + qi) << 24);
        float pr[16];
#pragma unroll
        for (int r = 0; r < 16; ++r) { const int rowb = ((r & 3) + 8 * (r >> 2)) * OSTR; float ps = 0.f; float vs[4];
#pragma unroll
            for (int d0 = 0; d0 < 4; ++d0) { const float v = o[d0][r] * rli[r]; ps += v * v; vs[d0] = __builtin_amdgcn_fmed3f(v * OSCALE, -448.f, 448.f); }
            int W = __builtin_amdgcn_cvt_pk_fp8_f32(vs[0], vs[1], 0, false); W = __builtin_amdgcn_cvt_pk_fp8_f32(vs[2], vs[3], W, true);
            const unsigned T0 = (unsigned)__builtin_amdgcn_mov_dpp(W, 0x00, 0xF, 0xF, true), T1 = (unsigned)__builtin_amdgcn_mov_dpp(W, 0x55, 0xF, 0xF, true);
            const unsigned T2 = (unsigned)__builtin_amdgcn_mov_dpp(W, 0xAA, 0xF, 0xF, true), T3 = (unsigned)__builtin_amdgcn_mov_dpp(W, 0xFF, 0xF, 0xF, true);
            const unsigned R = __builtin_amdgcn_perm(T1, T0, selA) | __builtin_amdgcn_perm(T3, T2, selB);
            __builtin_amdgcn_raw_buffer_store_b32(R, rO, voff, rowb, 0);
            pr[r] = ps; }
        float p8[8], p4[4], p2[2], p1;
        { const bool b = (r32 & 16) != 0;
#pragma unroll
          for (int i = 0; i < 8; ++i) { const float keep = b ? pr[i + 8] : pr[i], send = b ? pr[i] : pr[i + 8]; p8[i] = keep + __shfl_xor(send, 16); } }
        { const bool b = (r32 & 8) != 0;
#pragma unroll
          for (int i = 0; i < 4; ++i) { const float keep = b ? p8[i + 4] : p8[i], send = b ? p8[i] : p8[i + 4]; p4[i] = keep + __shfl_xor(send, 8); } }
        { const bool b = (r32 & 4) != 0;
#pragma unroll
          for (int i = 0; i < 2; ++i) { const float keep = b ? p4[i + 2] : p4[i], send = b ? p4[i] : p4[i + 2]; p2[i] = keep + __shfl_xor(send, 4); } }
        { const bool b = (r32 & 2) != 0; const float keep = b ? p2[1] : p2[0], send = b ? p2[0] : p2[1]; p1 = keep + __shfl_xor(send, 2); }
        p1 += __shfl_xor(p1, 1);
        { const int r = ((r32 >> 4) & 1) * 8 + ((r32 >> 3) & 1) * 4 + ((r32 >> 2) & 1) * 2 + ((r32 >> 1) & 1);
          if ((r32 & 1) == 0) atomicAdd(cur.SSQ + wid * QBLK + (r & 3) + 8 * (r >> 2) + 4 * hi, p1); }
    }
    __syncthreads();
#undef RESC
#undef KBASE
#undef MASKT
#undef SEAM_K0
#undef HALF_STEP
}
#undef ROW
#undef VMW
#undef VMWN
#undef SLOAD_H
#undef SWRITE_HK
#undef SWRITE_HV
#undef SWRITE_H
}
struct Args { const float* in[23]; float* out; unsigned char* ws; int ph_lo, ph_hi; };
struct Frame {
    LAS unsigned char* lds;
    volatile LAS unsigned* MISC;
    gu32* ctl;
    int tid, lane, wave;
    int vcu, G;
    float* out; unsigned char* ws;
};
enum { I_X = 0, I_GMIX, I_WIN, I_RELB, I_LRE, I_LIM, I_LDT, I_BRE, I_BIM, I_CRE, I_CIM, I_SD, I_WGLU, I_GATT, I_GSSM, I_WOUT, I_GFFN, I_WQ, I_KA, I_KB, I_PU, I_PV, I_GFIN };

struct TrDesc { const float* W; bf16* WT; const float* ks0; const float* ks1; int K, N, ksplit, item; float f8scale; int ldw; };
__device__ __forceinline__ void tr_load(const TrDesc& d, f32x4 (&v)[8], int lane) {
    const int nblk = d.N / 32, kb = d.item / nblk, nb = d.item % nblk, k0 = 64 * kb, n0 = 32 * nb;
#pragma unroll
    for (int i = 0; i < 8; ++i) { const int k = k0 + 8 * i + (lane >> 3);
        f32x4 t = *(const GAS f32x4*)(d.W + (size_t)k * d.ldw + n0 + (lane & 7) * 4);
        if (d.ks0) { const float sc = (k < d.ksplit) ? d.ks0[k] : d.ks1[k - d.ksplit]; t = t * sc; }
        v[i] = t; }
}
__device__ __forceinline__ void tr_store(const TrDesc& d, const f32x4 (&v)[8], LAS float* scr, int lane) {
    const int nblk = d.N / 32, kb = d.item / nblk, nb = d.item % nblk, k0 = 64 * kb, n0 = 32 * nb;
#pragma unroll
    for (int i = 0; i < 8; ++i) { LAS float* w = scr + (8 * i + (lane >> 3)) * 33 + (lane & 7) * 4; w[0] = v[i].x; w[1] = v[i].y; w[2] = v[i].z; w[3] = v[i].w; }
    LDS_WAIT(); asm volatile("" ::: "memory");
    const int c = lane & 7;
#pragma unroll
    for (int j = 0; j < 4; ++j) { const int n = (lane >> 3) + 8 * j; const LAS float* s = scr + (8 * c) * 33 + n;
        if (d.f8scale != 0.f) { const float q = d.f8scale; v2u o8; o8.x = pg8::pk4_fp8(s[0 * 33] * q, s[1 * 33] * q, s[2 * 33] * q, s[3 * 33] * q); o8.y = pg8::pk4_fp8(s[4 * 33] * q, s[5 * 33] * q, s[6 * 33] * q, s[7 * 33] * q);
            *(GAS v2u*)((unsigned char*)d.WT + (size_t)(n0 + n) * d.K + k0 + 8 * c) = o8; }
        else { v4u o; o.x = pk2(s[0 * 33], s[1 * 33]); o.y = pk2(s[2 * 33], s[3 * 33]); o.z = pk2(s[4 * 33], s[5 * 33]); o.w = pk2(s[6 * 33], s[7 * 33]);
            *(GAS v4u*)(d.WT + (size_t)(n0 + n) * d.K + k0 + 8 * c) = o; } }
    LDS_WAIT(); asm volatile("" ::: "memory");
}
__device__ __forceinline__ int t5_bucket(int n) {
    if (n < 16) return n;
    const float ratio = logf((float)n / 16.0f) / 2.0794415416798357f;
    int large = 16 + (int)(ratio * 16.0f);
    return large < 31 ? large : 31;
}
__device__ __forceinline__ void p0_prologue(Frame& F, const Args& A, int parts) {
    LAS float* scr = (LAS float*)(F.lds + RING_OFF + F.wave * 16384);
    const int gw = F.vcu * NWAVES + F.wave, NGW = F.G * NWAVES;
    bf16* Win_t = (bf16*)(F.ws + WS_WIN); bf16* Wglu_t = (bf16*)(F.ws + WS_WGLU); bf16* Wout_t = (bf16*)(F.ws + WS_WOUT); bf16* Wq_t = (bf16*)(F.ws + WS_WQ);
    constexpr int I_IN = (DM / 64) * (NSPLIT / 32), I_IN8 = (DM / 64) * ((NIN - NSPLIT) / 32), I_GL = (SW / 64) * (SW / 32), I_OUT = (DM / 64) * (DM / 32), I_Q = (DM / 64) * (2048 / 32);
    constexpr int NITEMS = I_IN + I_IN8 + I_GL + I_OUT + I_Q;
#define TR_DESC(d, it_) do { int r_ = (it_); \
        if (r_ < I_IN) { d = TrDesc{A.in[I_WIN], Win_t, nullptr, nullptr, DM, NSPLIT, 0, r_, 0.f, NIN}; } \
        else if ((r_ -= I_IN) < I_IN8) { d = TrDesc{A.in[I_WIN] + NSPLIT, (bf16*)(F.ws + WS_WIN8), nullptr, nullptr, DM, NIN - NSPLIT, 0, r_, pg8::FP8_SWI, NIN}; } \
        else if ((r_ -= I_IN8) < I_GL) { d = TrDesc{A.in[I_WGLU], Wglu_t, nullptr, nullptr, SW, SW, 0, r_, pg8::FP8_SWG, SW}; } \
        else if ((r_ -= I_GL) < I_OUT) { d = TrDesc{A.in[I_WOUT], Wout_t, A.in[I_GATT], A.in[I_GSSM], DM, DM, AW, r_, pg8::FP8_SWO, DM}; } \
        else { r_ -= I_OUT; d = TrDesc{A.in[I_WQ], Wq_t, A.in[I_GFFN], A.in[I_GFFN], DM, 2048, DM, r_, pg8::FP8_SWQ, 2048}; } } while (0)
    const int it_lo = (parts & 4) ? 0 : I_IN + I_IN8, it_hi = (parts & 1) ? NITEMS : I_IN + I_IN8;
    for (int it = it_lo + gw; it < it_hi; it += 2 * NGW) {
        const int itb = it + NGW; const bool hb = itb < it_hi;
        TrDesc da, db; TR_DESC(da, it); TR_DESC(db, hb ? itb : it);
        f32x4 va[8], vb[8];
        tr_load(da, va, F.lane); tr_load(db, vb, F.lane);
        tr_store(da, va, scr, F.lane);
        if (hb) tr_store(db, vb, scr, F.lane);
    }
#undef TR_DESC
    if (parts & 2) {
        bf16* Hb = (bf16*)(F.ws + WS_H); const float* x = A.in[I_X]; const GAS f32x4* gp = (const GAS f32x4*)A.in[I_GMIX] + F.lane;
        f32x4 gg[16];
#pragma unroll
        for (int j = 0; j < 16; ++j) gg[j] = gp[64 * j];
        for (int m = gw; m < T; m += NGW) {
            const GAS f32x4* xr = (const GAS f32x4*)(x + (size_t)m * DM) + F.lane;
            f32x4 v[16]; float s = 0.f;
#pragma unroll
            for (int j = 0; j < 16; ++j) { v[j] = xr[64 * j]; s += (v[j].x * v[j].x + v[j].y * v[j].y) + (v[j].z * v[j].z + v[j].w * v[j].w); }
            const float r = 1.0f / sqrtf(wave_sum(s) * (1.0f / DM) + RMS_EPS);
            GAS v2u* o8 = (GAS v2u*)(Hb + (size_t)m * DM) + F.lane; GAS unsigned* h8 = (GAS unsigned*)(F.ws + WS_H8 + (size_t)m * DM) + F.lane;
#pragma unroll
            for (int j = 0; j < 16; ++j) { const f32x4 g = gg[j]; const float h0 = v[j].x * r * g.x, h1 = v[j].y * r * g.y, h2 = v[j].z * r * g.z, h3 = v[j].w * r * g.w;
                v2u w; w.x = pk2(h0, h1); w.y = pk2(h2, h3); o8[64 * j] = w;
                h8[64 * j] = pg8::pk4_fp8(h0 * pg8::FP8_SH, h1 * pg8::FP8_SH, h2 * pg8::FP8_SH, h3 * pg8::FP8_SH); }
        }
    }
    if (parts & 1) {
        bf16* Kb = (bf16*)(F.ws + WS_KEYS); const int gt = (F.vcu * NWAVES + F.wave) * 64 + F.lane, NT_ = F.G * NWAVES * 64;
        for (int i = gt; i < 2 * PH * PK * 128; i += NT_) { const float v = i < PH * PK * 128 ? A.in[I_KA][i] : A.in[I_KB][i - PH * PK * 128]; Kb[i] = (bf16)f2bf(v); }
        float* bl = (float*)(F.ws + WS_BLUT);
        for (int i = gt; i < NH * 128; i += NT_) { const int h = i >> 7, d = i & 127; bl[i] = A.in[I_RELB][t5_bucket(d) * NH + h]; }
    }
}

__device__ __forceinline__ void ssm_naive_item(Frame& F, const Args& A, int item) {
    const int b = item >> 7, g = item & 127; const int tid = F.tid;
    LAS float* L = (LAS float*)(F.lds + RING_OFF);
    LAS float* Bre = L;
    LAS float* Bim = Bre + 64 * 17;
    LAS float* Cre = Bim + 64 * 17;
    LAS float* Cim = Cre + 16 * 65;
    LAS float* Are = Cim + 16 * 65;
    LAS float* Aim = Are + 64;
    LAS float* Hb = Aim + 64;
    LAS unsigned short* Ul = (LAS unsigned short*)(Hb + 2 * 16 * 129 + 4);
    const bf16* ub = (const bf16*)(F.ws + WS_U); bf16* yg = (bf16*)(F.ws + WS_YG);
    __syncthreads();
    if (tid < 64) {
        const int p = tid; const float lre = A.in[I_LRE][g * 64 + p], lim = A.in[I_LIM][g * 64 + p];
        const double dt = exp((double)A.in[I_LDT][g]);
        const double mag = exp((double)lre * dt); const double ph = (double)lim * dt;
        const double kk = rint(ph / 6.283185307179586476925); const float phr = (float)(ph - kk * 6.283185307179586476925);
        const float are = (float)mag * cosf(phr), aim = (float)mag * sinf(phr);
        Are[p] = are; Aim[p] = aim;
        const float den = lre * lre + lim * lim; const float nr = are - 1.0f, ni = aim;
        const float cre = (nr * lre + ni * lim) / den, cim = (ni * lre - nr * lim) / den;
#pragma unroll
        for (int c = 0; c < 16; ++c) { const float br = A.in[I_BRE][(g * 64 + p) * 16 + c], bi = A.in[I_BIM][(g * 64 + p) * 16 + c];
            Bre[p * 17 + c] = cre * br - cim * bi; Bim[p * 17 + c] = cre * bi + cim * br; }
    }
    for (int i = tid; i < 1024; i += 512) { const int c = i >> 6, p = i & 63; Cre[c * 65 + p] = A.in[I_CRE][(g * 16 + c) * 64 + p]; Cim[c * 65 + p] = A.in[I_CIM][(g * 16 + c) * 64 + p]; }
    for (int i = tid; i < 4096; i += 512) { const int t = i >> 1, hf = i & 1; const v4u w = *(const GAS v4u*)(ub + (size_t)(b * SEQ + t) * 2048 + g * 16 + hf * 8); *(LAS v4u*)(Ul + t * 16 + hf * 8) = w; }
    __syncthreads();
    float hre = 0.f, him = 0.f;
    const float are = (tid >= 448) ? Are[tid - 448] : 0.f, aim = (tid >= 448) ? Aim[tid - 448] : 0.f;
    for (int ck = 0; ck <= 128; ++ck) {
        if (tid >= 448 && ck < 128) {
            const int p = tid - 448; LAS float* hb = Hb + (ck & 1) * 16 * 129;
            for (int s = 0; s < 16; ++s) { const int t = ck * 16 + s; float bur = 0.f, bui = 0.f;
#pragma unroll
                for (int c = 0; c < 16; ++c) { const float uv = bf2f(Ul[t * 16 + c]); bur += Bre[p * 17 + c] * uv; bui += Bim[p * 17 + c] * uv; }
                const float nre = are * hre - aim * him + bur, nim = are * him + aim * hre + bui; hre = nre; him = nim;
                hb[s * 129 + p] = hre; hb[s * 129 + 64 + p] = him; }
        }
        if (tid < 256 && ck > 0) {
            const int s = tid >> 4, c = tid & 15; const LAS float* hb = Hb + ((ck - 1) & 1) * 16 * 129 + s * 129; float y = 0.f;
#pragma unroll 8
            for (int p = 0; p < 64; ++p) y += Cre[c * 65 + p] * hb[p] - Cim[c * 65 + p] * hb[64 + p];
            const int t = (ck - 1) * 16 + s; const float uv = bf2f(Ul[t * 16 + c]);
            y += A.in[I_SD][g * 16 + c] * uv;
            yg[(size_t)(b * SEQ + t) * SW + g * 16 + c] = (bf16)f2bf(gelu_erf(y));
        }
        __syncthreads();
    }
}
__device__ __forceinline__ void kmean_item(Frame& F, int item) {
    const int bh = item >> 3, blk = item & 7; const int tid = F.tid, kg = tid >> 4, c = tid & 15;
    const bf16* kb = (const bf16*)(F.ws + WS_QKV) + (size_t)T * 2048 + ((size_t)bh * SEQ + blk * 256 + kg * 8) * HD + c * 8;
    LAS float* L = (LAS float*)(F.lds + RING_OFF);
    v4u w[8];
#pragma unroll
    for (int i = 0; i < 8; ++i) w[i] = *(const GAS v4u*)(kb + (size_t)i * HD);
    float s[8] = {0.f, 0.f, 0.f, 0.f, 0.f, 0.f, 0.f, 0.f};
#pragma unroll
    for (int i = 0; i < 8; ++i) { s[0] += bflo(w[i].x); s[1] += bfhi(w[i].x); s[2] += bflo(w[i].y); s[3] += bfhi(w[i].y); s[4] += bflo(w[i].z); s[5] += bfhi(w[i].z); s[6] += bflo(w[i].w); s[7] += bfhi(w[i].w); }
    __syncthreads();
    *(LAS f32x4*)(L + kg * 128 + c * 8) = (f32x4){s[0], s[1], s[2], s[3]}; *(LAS f32x4*)(L + kg * 128 + c * 8 + 4) = (f32x4){s[4], s[5], s[6], s[7]};
    __syncthreads();
    if (tid < 128) { float a = 0.f;
#pragma unroll 8
        for (int g = 0; g < 32; ++g) a += L[g * 128 + tid];
        ((float*)(F.ws + WS_KMEAN))[(size_t)item * 128 + tid] = a * (1.0f / 256.0f); }
}

__device__ __forceinline__ void attn_naive_item(Frame& F, int item) {
    const int bh = item >> 8, rg = item & 255; const int b = bh >> 4, h = bh & 15;
    const int s = rg * 8 + F.wave, qblk = s >> 8, lane = F.lane;
    const bf16* qb = (const bf16*)(F.ws + WS_QKV) + ((size_t)bh * SEQ + s) * HD;
    const bf16* kb = (const bf16*)(F.ws + WS_QKV) + (size_t)T * 2048 + (size_t)bh * SEQ * HD;
    const bf16* vb = (const bf16*)(F.ws + WS_QKV) + (size_t)2 * T * 2048 + (size_t)bh * SEQ * HD;
    const float* km = (const float*)(F.ws + WS_KMEAN) + (size_t)bh * 8 * 128;
    const float* bl = (const float*)(F.ws + WS_BLUT) + h * 128;
    LAS float* qs = (LAS float*)(F.lds + RING_OFF) + F.wave * 128;
    const float q0 = bf2f(qb[lane]), q1 = bf2f(qb[lane + 64]);
    qs[lane] = q0; qs[lane + 64] = q1;
    float gate[7];
#pragma unroll
    for (int j = 0; j < 7; ++j) { float gsum = 0.f; if (j < qblk) gsum = wave_sum(q0 * km[j * 128 + lane] + q1 * km[j * 128 + lane + 64]); gate[j] = (j < qblk) ? gsum : -3.0e38f; }
    unsigned selmask = 0u;
#pragma unroll
    for (int r = 0; r < 3; ++r) { if (r < qblk) { float best = 0.f; int bi = -1;
#pragma unroll
            for (int j = 0; j < 7; ++j) { if (j < qblk && !((selmask >> j) & 1u) && (bi < 0 || gate[j] > best)) { best = gate[j]; bi = j; } }
            selmask |= 1u << bi; } }
    unsigned blocks = selmask | (1u << qblk);
    const int nslots = __popc(blocks);
    LDS_WAIT();
    float sc[4][4]; int sj[4];
    const float scale = 0.08838834764831845f;
#pragma unroll
    for (int sl = 0; sl < 4; ++sl) {
        int j = 0; if (sl < nslots) { j = __ffs(blocks) - 1; blocks &= blocks - 1; } sj[sl] = j;
#pragma unroll
        for (int i = 0; i < 4; ++i) {
            float v = -__builtin_inff();
            if (sl < nslots) {
                const int key = j * 256 + i * 64 + lane; const GAS v4u* kr = (const GAS v4u*)(kb + (size_t)key * HD); float dot = 0.f;
#pragma unroll 4
                for (int c = 0; c < 16; ++c) { const v4u w = kr[c]; const LAS f32x4* qv = (const LAS f32x4*)(qs + c * 8); const f32x4 qa = qv[0], qb4 = qv[1];
                    dot += bflo(w.x) * qa.x + bfhi(w.x) * qa.y + bflo(w.y) * qa.z + bfhi(w.y) * qa.w + bflo(w.z) * qb4.x + bfhi(w.z) * qb4.y + bflo(w.w) * qb4.z + bfhi(w.w) * qb4.w; }
                const int dist = s - key;
                if (dist >= 0) v = dot * scale + bl[dist < 127 ? dist : 127];
            }
            sc[sl][i] = v;
        }
    }
    float mx = -__builtin_inff();
#pragma unroll
    for (int sl = 0; sl < 4; ++sl)
#pragma unroll
        for (int i = 0; i < 4; ++i) mx = fmaxf(mx, sc[sl][i]);
    mx = wave_max(mx);
    float sum = 0.f;
#pragma unroll
    for (int sl = 0; sl < 4; ++sl)
#pragma unroll
        for (int i = 0; i < 4; ++i) { const float p = __builtin_amdgcn_exp2f((sc[sl][i] - mx) * LOG2E); sc[sl][i] = p; sum += p; }
    sum = wave_sum(sum);
    float o0 = 0.f, o1 = 0.f;
#pragma unroll
    for (int sl = 0; sl < 4; ++sl) {
        if (sl < nslots) {
#pragma unroll
            for (int i = 0; i < 4; ++i) {
                const bf16* vr = vb + (size_t)(sj[sl] * 256 + i * 64) * HD + lane;
                const float pv = sc[sl][i];
#pragma unroll 8
                for (int l = 0; l < 64; ++l) { const float p = __int_as_float(__builtin_amdgcn_readlane(__float_as_int(pv), l));
                    o0 += p * bf2f(vr[(size_t)l * HD]); o1 += p * bf2f(vr[(size_t)l * HD + 64]); }
            }
        }
    }
    const float inv = 1.0f / sum; o0 *= inv; o1 *= inv;
    const int token = b * SEQ + s;
    bf16* yc = (bf16*)(F.ws + WS_YCAT) + (size_t)token * DM + h * HD;
    yc[lane] = (bf16)f2bf(o0); yc[lane + 64] = (bf16)f2bf(o1);
    const float ss = wave_sum(o0 * o0 + o1 * o1);
    if (lane == 0) atomicAdd((float*)(F.ctl + CW_SSQA) + token, ss);
    LDS_WAIT();
}

__device__ __forceinline__ void ynorm_phase(Frame& F) {
    const int gw = F.vcu * NWAVES + F.wave, NGW = F.G * NWAVES;
    bf16* yc = (bf16*)(F.ws + WS_YCAT);
    for (int m = gw; m < T; m += NGW) {
        GAS v4u* p = (GAS v4u*)(yc + (size_t)m * DM) + F.lane;
        v4u w[8]; float sa = 0.f, ss = 0.f;
#pragma unroll
        for (int j = 0; j < 8; ++j) { w[j] = p[64 * j];
            const float q = (bflo(w[j].x) * bflo(w[j].x) + bfhi(w[j].x) * bfhi(w[j].x)) + (bflo(w[j].y) * bflo(w[j].y) + bfhi(w[j].y) * bfhi(w[j].y))
                          + (bflo(w[j].z) * bflo(w[j].z) + bfhi(w[j].z) * bfhi(w[j].z)) + (bflo(w[j].w) * bflo(w[j].w) + bfhi(w[j].w) * bfhi(w[j].w));
            if (j < 4) sa += q; else ss += q; }
        const float ra = 1.0f / sqrtf(wave_sum(sa) * (1.0f / AW) + RMS_EPS);
        const float rs = 1.0f / sqrtf(wave_sum(ss) * (1.0f / SW) + RMS_EPS);
#pragma unroll
        for (int j = 0; j < 8; ++j) { const float r = j < 4 ? ra : rs; v4u o;
            o.x = pk2(bflo(w[j].x) * r, bfhi(w[j].x) * r); o.y = pk2(bflo(w[j].y) * r, bfhi(w[j].y) * r); o.z = pk2(bflo(w[j].z) * r, bfhi(w[j].z) * r); o.w = pk2(bflo(w[j].w) * r, bfhi(w[j].w) * r);
            p[64 * j] = o; }
    }
}

__device__ __forceinline__ void topk_naive_phase(Frame& F) {
    const int gw = F.vcu * NWAVES + F.wave, NGW = F.G * NWAVES, lane = F.lane;
    const bf16* qp = (const bf16*)(F.ws + WS_QP); const bf16* keys = (const bf16*)(F.ws + WS_KEYS);
    int* ex = (int*)(F.ws + WS_EXP); float* gt = (float*)(F.ws + WS_GATE);
    LAS float* qs = (LAS float*)(F.lds + RING_OFF) + F.wave * 256;
    for (int it = gw; it < T * PH; it += NGW) {
        const int tok = it >> 3, h = it & 7;
        { const v2u w = *(const GAS v2u*)(qp + (size_t)tok * 2048 + h * 256 + lane * 4); qs[lane * 4 + 0] = bflo(w.x); qs[lane * 4 + 1] = bfhi(w.x); qs[lane * 4 + 2] = bflo(w.y); qs[lane * 4 + 3] = bfhi(w.y); }
        LDS_WAIT();
        float sv[2][2];
#pragma unroll
        for (int side = 0; side < 2; ++side)
#pragma unroll
            for (int kk = 0; kk < 2; ++kk) {
                const GAS v4u* kr = (const GAS v4u*)(keys + ((size_t)(side * PH + h) * PK + kk * 64 + lane) * 128); float dot = 0.f;
#pragma unroll 4
                for (int c = 0; c < 16; ++c) { const v4u w = kr[c]; const LAS f32x4* qv = (const LAS f32x4*)(qs + side * 128 + c * 8); const f32x4 qa = qv[0], qb4 = qv[1];
                    dot += bflo(w.x) * qa.x + bfhi(w.x) * qa.y + bflo(w.y) * qa.z + bfhi(w.y) * qa.w + bflo(w.z) * qb4.x + bfhi(w.z) * qb4.y + bflo(w.w) * qb4.z + bfhi(w.w) * qb4.w; }
                sv[side][kk] = dot;
            }
        float tv[2]; int ti[2];
#pragma unroll
        for (int side = 0; side < 2; ++side) {
            float v0 = sv[side][0], v1 = sv[side][1]; float keepv = 0.f; int keepi = 0;
            for (int r = 0; r < 16; ++r) {
                float bv = v0 >= v1 ? v0 : v1; int bi = v0 >= v1 ? lane : lane + 64;
#pragma unroll
                for (int o = 1; o < 64; o <<= 1) { const float ov = __shfl_xor(bv, o); const int oi = __shfl_xor(bi, o); if (ov > bv || (ov == bv && oi < bi)) { bv = ov; bi = oi; } }
                if (lane == r) { keepv = bv; keepi = bi; }
                if (bi == lane) v0 = -__builtin_inff(); if (bi == lane + 64) v1 = -__builtin_inff();
            }
            tv[side] = keepv; ti[side] = keepi;
        }
        float cv[4];
        { const float vai = __shfl(tv[0], lane >> 2);
#pragma unroll
          for (int m = 0; m < 4; ++m) cv[m] = vai + __shfl(tv[1], (lane & 3) * 4 + m); }
        float bestv = 0.f; int bestc = 0;
        for (int r = 0; r < 16; ++r) {
            float bv = cv[0]; int bi = lane * 4;
#pragma unroll
            for (int m = 1; m < 4; ++m) if (cv[m] > bv) { bv = cv[m]; bi = lane * 4 + m; }
#pragma unroll
            for (int o = 1; o < 64; o <<= 1) { const float ov = __shfl_xor(bv, o); const int oi = __shfl_xor(bi, o); if (ov > bv || (ov == bv && oi < bi)) { bv = ov; bi = oi; } }
            if (lane == r) { bestv = bv; bestc = bi; }
#pragma unroll
            for (int m = 0; m < 4; ++m) if (bi == lane * 4 + m) cv[m] = -__builtin_inff();
        }
        const float vmax = __shfl(bestv, 0);
        const float ev = lane < 16 ? __builtin_amdgcn_exp2f((bestv - vmax) * LOG2E) : 0.f;
        const float esum = wave_sum(ev);
        const int ea = __shfl(ti[0], bestc >> 4), eb = __shfl(ti[1], bestc & 15);
        if (lane < 16) { ex[(size_t)tok * PSEL + h * 16 + lane] = ea * PK + eb; gt[(size_t)tok * PSEL + h * 16 + lane] = ev / esum; }
    }
}

__device__ __forceinline__ att::BlockRef attn_ref(Frame& F, int L, int pass) {
    const int bh = L >> 2, x = L & 3, qb = pass ? 7 - x : x; const int b = bh >> 4, h = bh & 15;
    att::BlockRef r;
    const bf16* base = (const bf16*)(F.ws + WS_QKV);
    r.Q = base + ((size_t)bh * SEQ + qb * 256) * HD;
    r.K = base + (size_t)T * 2048 + (size_t)bh * SEQ * HD;
    r.V = base + (size_t)2 * T * 2048 + (size_t)bh * SEQ * HD;
    r.O = (bf16*)(F.ws + WS_YCAT + ((size_t)(b * SEQ + qb * 256)) * DM + h * HD);
    r.KM = (const float*)(F.ws + WS_KMEAN) + (size_t)bh * 1024;
    r.BL = (const float*)(F.ws + WS_BLUT) + h * 128;
    r.SSQ = (float*)(F.ctl + CW_SSQAT) + (b * SEQ + qb * 256);
    r.P0 = qb * 256;
    return r;
}
__device__ __forceinline__ void attn_mfma_phase(Frame& F, unsigned char* ldsg) {
    const int total = BATCH * NH * 4, stride = F.G;
    int L = F.vcu; if (L >= total) return;
    int pass = 0;
    att::BlockRef cur = attn_ref(F, L, 0);
    att::Seam S;
    att::moba_prime(cur, (char*)ldsg + RING_OFF, S);
    for (;;) {
        const bool more_pass = pass == 0, more_item = L + stride < total, last = !more_pass && !more_item;
        int passn = pass + 1, Ln = L;
        if (!more_pass) { passn = 0; Ln = more_item ? L + stride : L; }
        const att::BlockRef nxt = last ? cur : attn_ref(F, Ln, passn);
        att::moba_block(cur, nxt, (char*)ldsg + RING_OFF, F.lds + RING_OFF, S);
        if (last) break;
        cur = nxt; pass = passn; L = Ln;
    }
}
typedef short tk_bf16x8 __attribute__((ext_vector_type(8)));
typedef float tk_f32x16 __attribute__((ext_vector_type(16)));
__device__ __forceinline__ unsigned ordkey(float v) { const unsigned u = __float_as_uint(v); return u ^ ((unsigned)((int)u >> 31) | 0x80000000u); }
__device__ __forceinline__ float ordval(unsigned k) { const unsigned u = (k & 0x80000000u) ? (k ^ 0x80000000u) : ~k; return __uint_as_float(u); }
#define TK_INSERT(lst, key) do { unsigned nk_ = (key); _Pragma("unroll") for (int q_ = 0; q_ < 16; ++q_) { const unsigned hi_ = lst[q_] > nk_ ? lst[q_] : nk_; nk_ = lst[q_] > nk_ ? nk_ : lst[q_]; lst[q_] = hi_; } } while (0)
#define TK_CE(a, b) do { const unsigned hi_ = (a) > (b) ? (a) : (b); const unsigned lo_ = (a) > (b) ? (b) : (a); (a) = hi_; (b) = lo_; } while (0)
__device__ __forceinline__ void tk_bitonic_merge16(unsigned (&x)[16]) {
    TK_CE(x[0], x[8]); TK_CE(x[1], x[9]); TK_CE(x[2], x[10]); TK_CE(x[3], x[11]); TK_CE(x[4], x[12]); TK_CE(x[5], x[13]); TK_CE(x[6], x[14]); TK_CE(x[7], x[15]); TK_CE(x[0], x[4]); TK_CE(x[1], x[5]); TK_CE(x[2], x[6]); TK_CE(x[3], x[7]); TK_CE(x[8], x[12]); TK_CE(x[9], x[13]); TK_CE(x[10], x[14]); TK_CE(x[11], x[15]); TK_CE(x[0], x[2]); TK_CE(x[1], x[3]); TK_CE(x[4], x[6]); TK_CE(x[5], x[7]); TK_CE(x[8], x[10]); TK_CE(x[9], x[11]); TK_CE(x[12], x[14]); TK_CE(x[13], x[15]); TK_CE(x[0], x[1]); TK_CE(x[2], x[3]); TK_CE(x[4], x[5]); TK_CE(x[6], x[7]); TK_CE(x[8], x[9]); TK_CE(x[10], x[11]); TK_CE(x[12], x[13]); TK_CE(x[14], x[15]);
}
__device__ __forceinline__ void tk_sort16(unsigned (&x)[16]) {
    TK_CE(x[0], x[1]); TK_CE(x[3], x[2]); TK_CE(x[4], x[5]); TK_CE(x[7], x[6]); TK_CE(x[8], x[9]); TK_CE(x[11], x[10]); TK_CE(x[12], x[13]); TK_CE(x[15], x[14]); TK_CE(x[0], x[2]); TK_CE(x[1], x[3]); TK_CE(x[6], x[4]); TK_CE(x[7], x[5]); TK_CE(x[8], x[10]); TK_CE(x[9], x[11]); TK_CE(x[14], x[12]); TK_CE(x[15], x[13]); TK_CE(x[0], x[1]); TK_CE(x[2], x[3]); TK_CE(x[5], x[4]); TK_CE(x[7], x[6]); TK_CE(x[8], x[9]); TK_CE(x[10], x[11]); TK_CE(x[13], x[12]); TK_CE(x[15], x[14]); TK_CE(x[0], x[4]); TK_CE(x[1], x[5]); TK_CE(x[2], x[6]); TK_CE(x[3], x[7]); TK_CE(x[12], x[8]); TK_CE(x[13], x[9]); TK_CE(x[14], x[10]); TK_CE(x[15], x[11]); TK_CE(x[0], x[2]); TK_CE(x[1], x[3]); TK_CE(x[4], x[6]); TK_CE(x[5], x[7]); TK_CE(x[10], x[8]); TK_CE(x[11], x[9]); TK_CE(x[14], x[12]); TK_CE(x[15], x[13]); TK_CE(x[0], x[1]); TK_CE(x[2], x[3]); TK_CE(x[4], x[5]); TK_CE(x[6], x[7]); TK_CE(x[9], x[8]); TK_CE(x[11], x[10]); TK_CE(x[13], x[12]); TK_CE(x[15], x[14]); TK_CE(x[0], x[8]); TK_CE(x[1], x[9]); TK_CE(x[2], x[10]); TK_CE(x[3], x[11]); TK_CE(x[4], x[12]); TK_CE(x[5], x[13]); TK_CE(x[6], x[14]); TK_CE(x[7], x[15]); TK_CE(x[0], x[4]); TK_CE(x[1], x[5]); TK_CE(x[2], x[6]); TK_CE(x[3], x[7]); TK_CE(x[8], x[12]); TK_CE(x[9], x[13]); TK_CE(x[10], x[14]); TK_CE(x[11], x[15]); TK_CE(x[0], x[2]); TK_CE(x[1], x[3]); TK_CE(x[4], x[6]); TK_CE(x[5], x[7]); TK_CE(x[8], x[10]); TK_CE(x[9], x[11]); TK_CE(x[12], x[14]); TK_CE(x[13], x[15]); TK_CE(x[0], x[1]); TK_CE(x[2], x[3]); TK_CE(x[4], x[5]); TK_CE(x[6], x[7]); TK_CE(x[8], x[9]); TK_CE(x[10], x[11]); TK_CE(x[12], x[13]); TK_CE(x[14], x[15]);
}
__device__ __forceinline__ void tk_top16_merge(unsigned (&a)[16], const unsigned (&b)[16]) {
#pragma unroll
    for (int i = 0; i < 16; ++i) a[i] = a[i] > b[15 - i] ? a[i] : b[15 - i];
    tk_bitonic_merge16(a);
}
__device__ __forceinline__ void topk_mfma_item(Frame& F, int item) {
    const int tile = item >> 3, head = item & 7, tok0 = tile * 128; int tid = F.tid; asm volatile("" : "+v"(tid));
    const int lane = tid & 63, wave = F.wave;
    const bf16* qp = (const bf16*)(F.ws + WS_QP); const bf16* keys = (const bf16*)(F.ws + WS_KEYS);
    LAS float* sc = (LAS float*)(F.lds + RING_OFF);
    LAS unsigned* lists = (LAS unsigned*)(F.lds + RING_OFF);
    __syncthreads();
    {
        const int side = wave >> 2, rt = wave & 3, r = lane & 31, hk = lane >> 5;
        tk_bf16x8 a[8];
        const bf16* ap = qp + (size_t)(tok0 + rt * 32 + r) * 2048 + head * 256 + side * 128 + hk * 8;
#pragma unroll
        for (int ks = 0; ks < 8; ++ks) a[ks] = *(const GAS tk_bf16x8*)(ap + ks * 16);
#pragma unroll
        for (int ct = 0; ct < 4; ++ct) {
            const bf16* bp = keys + ((size_t)(side * PH + head) * PK + ct * 32 + r) * 128 + hk * 8;
            tk_bf16x8 b[8];
#pragma unroll
            for (int ks = 0; ks < 8; ++ks) b[ks] = *(const GAS tk_bf16x8*)(bp + ks * 16);
            tk_f32x16 acc = {};
#pragma unroll
            for (int ks = 0; ks < 8; ++ks) acc = __builtin_amdgcn_mfma_f32_32x32x16_bf16(a[ks], b[ks], acc, 0, 0, 0);
#pragma unroll
            for (int rg = 0; rg < 16; ++rg) { const int row = rt * 32 + (rg & 3) + 8 * (rg >> 2) + 4 * hk, col = ct * 32 + r;
                sc[side * 16384 + row * 128 + (col ^ (row & 31))] = acc[rg]; }
        }
    }
    __syncthreads();
    unsigned lst[16];
    const int row = tid & 127, side = (tid >> 7) & 1, half = tid >> 8;
    {
        const int x = row & 31; const LAS float* sh = sc + side * 16384 + row * 128 + half * 64;
#pragma unroll
        for (int gq = 0; gq < 4; ++gq) { unsigned g[16];
#pragma unroll
            for (int q = 0; q < 16; ++q) { const int ph = gq * 16 + q; const float v = sh[ph]; g[q] = (ordkey(v) & ~127u) | (unsigned)(((127 - ph) ^ x) - half * 64); }
            tk_sort16(g);
            if (gq == 0) {
#pragma unroll
                for (int q = 0; q < 16; ++q) lst[q] = g[q]; }
            else tk_top16_merge(lst, g);
            __builtin_amdgcn_sched_barrier(0); }
    }
    __syncthreads();
    if (half == 1) {
#pragma unroll
        for (int q = 0; q < 16; ++q) lists[(side * 128 + row) * 17 + q] = lst[q];
    }
    __syncthreads();
    if (half == 0) { unsigned g[16];
#pragma unroll
        for (int q = 0; q < 16; ++q) g[q] = lists[(side * 128 + row) * 17 + q];
        tk_top16_merge(lst, g);
    }
    __syncthreads();
    if (half == 0) {
#pragma unroll
        for (int q = 0; q < 16; ++q) lists[(side * 128 + row) * 17 + q] = lst[q];
    }
    __syncthreads();
    if (tid < 128) {
        float va[16], vb[16];
#pragma unroll
        for (int q = 0; q < 16; ++q) { va[q] = ordval(lst[q] & ~127u); vb[q] = ordval(lists[(128 + row) * 17 + q] & ~127u); }
        unsigned cl[16], g1[16], g2[16], g3[16];
#define TK_CAND(i, j) ((ordkey(va[i] + vb[j]) & ~255u) | (unsigned)(255 - ((i) * 16 + (j))))
#pragma unroll
        for (int j = 0; j < 16; ++j) cl[j] = TK_CAND(0, j);
#pragma unroll
        for (int j = 0; j < 8; ++j) g1[j] = TK_CAND(1, j);
#pragma unroll
        for (int j = 0; j < 5; ++j) g1[8 + j] = TK_CAND(2, j);
        g1[13] = TK_CAND(5, 0); g1[14] = TK_CAND(5, 1); g1[15] = 0u;
#pragma unroll
        for (int j = 0; j < 4; ++j) g2[j] = TK_CAND(3, j);
#pragma unroll
        for (int j = 0; j < 3; ++j) g2[4 + j] = TK_CAND(4, j);
        g2[7] = TK_CAND(6, 0); g2[8] = TK_CAND(6, 1); g2[9] = TK_CAND(7, 0); g2[10] = TK_CAND(7, 1);
#pragma unroll
        for (int j = 11; j < 16; ++j) g2[j] = 0u;
#pragma unroll
        for (int i = 0; i < 8; ++i) { g3[i] = TK_CAND(8 + i, 0); g3[8 + i] = 0u; }
#undef TK_CAND
        tk_sort16(g1); tk_sort16(g2);
        tk_top16_merge(cl, g1); tk_top16_merge(g2, g3); tk_top16_merge(cl, g2);
        const float vmax = ordval(cl[0] & ~255u);
        float ev[16]; float es = 0.f; int ee[16];
#pragma unroll
        for (int q = 0; q < 16; ++q) { ev[q] = __builtin_amdgcn_exp2f((ordval(cl[q] & ~255u) - vmax) * LOG2E); es += ev[q];
            const int c = 255 - (int)(cl[q] & 255u); const int ia = 127 - (int)(lists[row * 17 + (c >> 4)] & 127u), ib = 127 - (int)(lists[(128 + row) * 17 + (c & 15)] & 127u);
            ee[q] = ia * PK + ib; }
        const float inv = 1.0f / es;
        int* ex = (int*)(F.ws + WS_EXP) + (size_t)(tok0 + row) * PSEL + head * 16; float* gt = (float*)(F.ws + WS_GATE) + (size_t)(tok0 + row) * PSEL + head * 16;
#pragma unroll
        for (int q = 0; q < 4; ++q) { *(GAS v4u*)(ex + q * 4) = (v4u){(unsigned)ee[4 * q], (unsigned)ee[4 * q + 1], (unsigned)ee[4 * q + 2], (unsigned)ee[4 * q + 3]};
            *(GAS f32x4*)(gt + q * 4) = (f32x4){ev[4 * q] * inv, ev[4 * q + 1] * inv, ev[4 * q + 2] * inv, ev[4 * q + 3] * inv}; }
    }
}
constexpr int SSM_L = 64, SSM_NCH = SEQ / SSM_L;
constexpr int SSM_KERN_G = 65 * 256;
constexpr int SSM_UROW = SSM_L * 32 + 16;
constexpr int SSM_LDS_U = 0, SSM_LDS_K = SSM_NCH * SSM_UROW, SSM_LDS_S = SSM_LDS_K + 65 * 512, SSM_LDS_H = SSM_LDS_S + 128 * 33 * 4, SSM_LDS_END = SSM_LDS_H + SSM_NCH * 272;
static_assert(SSM_LDS_END <= RING_BYTES, "ssm lds");
__device__ __forceinline__ void cpow_n(float lre, float lim, double dt, int n, float& re, float& im) {
    const double ph = (double)lim * dt * (double)n * 0.15915494309189533577; const float r = (float)(ph - rint(ph));
    const float mag = __builtin_amdgcn_exp2f((float)((double)lre * dt * (double)n) * 1.44269504088896f); re = mag * __builtin_amdgcn_cosf(r); im = mag * __builtin_amdgcn_sinf(r);
}
__device__ __forceinline__ void ssm_tables(Frame& F, const Args& A) {
    const int gw = F.vcu * NWAVES + F.wave, NGW = F.G * NWAVES, lane = F.lane;
    bf16* Wt = (bf16*)(F.ws + WS_SW); bf16* Vt = (bf16*)(F.ws + WS_SVM); bf16* Kt = (bf16*)(F.ws + WS_SKERN);
    __syncthreads();
    for (int it = gw; it < 16384 + SG * 13; it += NGW) {
        if (it < 8192) {
            const int g = it >> 6, p = it & 63; const float lre = A.in[I_LRE][g * 64 + p], lim = A.in[I_LIM][g * 64 + p]; const double dt = (double)expf(A.in[I_LDT][g]);
            float are, aim; cpow_n(lre, lim, dt, 1, are, aim);
            const float den = lre * lre + lim * lim, nr = are - 1.0f, ni = aim; const float cre = (nr * lre + ni * lim) / den, cim = (ni * lre - nr * lim) / den;
            float pr, pi; cpow_n(lre, lim, dt, 63 - lane, pr, pi);
            unsigned wr_[8], wi_[8];
#pragma unroll
            for (int c2 = 0; c2 < 8; ++c2) { float rr[2], ii[2];
#pragma unroll
                for (int e = 0; e < 2; ++e) { const int c = 2 * c2 + e; const float br = A.in[I_BRE][(g * 64 + p) * 16 + c], bi = A.in[I_BIM][(g * 64 + p) * 16 + c];
                    const float bbr = cre * br - cim * bi, bbi = cre * bi + cim * br; rr[e] = pr * bbr - pi * bbi; ii[e] = pr * bbi + pi * bbr; }
                wr_[c2] = pk2(rr[0], rr[1]); wi_[c2] = pk2(ii[0], ii[1]); }
            GAS v4u* dr = (GAS v4u*)(Wt + ((size_t)g * 128 + p) * 1024 + lane * 16); GAS v4u* di = (GAS v4u*)(Wt + ((size_t)g * 128 + 64 + p) * 1024 + lane * 16);
            dr[0] = (v4u){wr_[0], wr_[1], wr_[2], wr_[3]}; dr[1] = (v4u){wr_[4], wr_[5], wr_[6], wr_[7]};
            di[0] = (v4u){wi_[0], wi_[1], wi_[2], wi_[3]}; di[1] = (v4u){wi_[4], wi_[5], wi_[6], wi_[7]};
        } else if (it < 16384) {
            const int g = (it - 8192) >> 6, t = (it - 8192) & 63, p = lane; const float lre = A.in[I_LRE][g * 64 + p], lim = A.in[I_LIM][g * 64 + p]; const double dt = (double)expf(A.in[I_LDT][g]);
            float pr, pi; cpow_n(lre, lim, dt, t + 1, pr, pi);
            float cr[16], ci[16];
#pragma unroll
            for (int c = 0; c < 16; ++c) { cr[c] = A.in[I_CRE][(g * 16 + c) * 64 + p]; ci[c] = A.in[I_CIM][(g * 16 + c) * 64 + p]; }
#pragma unroll
            for (int c = 0; c < 16; ++c) { bf16* row = Vt + ((size_t)g * 1024 + t * 16 + c) * 128;
                row[p] = (bf16)f2bf(cr[c] * pr - ci[c] * pi); row[64 + p] = (bf16)f2bf(-(cr[c] * pi + ci[c] * pr)); }
        } else {
            const int r = it - 16384, g = r / 13, tb = r % 13; const int c = lane >> 2, cq = (lane & 3) * 4;
            float acc[5][4];
#pragma unroll
            for (int j = 0; j < 5; ++j)
#pragma unroll
                for (int e = 0; e < 4; ++e) acc[j][e] = 0.f;
            {
                LAS float* Lw = (LAS float*)(F.lds + RING_OFF) + F.wave * 4096;
                LAS float* Cre = Lw; LAS float* Cim = Lw + 1024; LAS float* Bre = Lw + 2048; LAS float* Bim = Lw + 3072;
                {
                    const GAS f32x4* s0 = (const GAS f32x4*)(A.in[I_CRE] + (size_t)g * 1024), * s1 = (const GAS f32x4*)(A.in[I_CIM] + (size_t)g * 1024);
                    const GAS f32x4* s2 = (const GAS f32x4*)(A.in[I_BRE] + (size_t)g * 1024), * s3 = (const GAS f32x4*)(A.in[I_BIM] + (size_t)g * 1024);
                    f32x4 t0[4], t1[4], t2[4], t3[4];
#pragma unroll
                    for (int i = 0; i < 4; ++i) { t0[i] = s0[i * 64 + lane]; t1[i] = s1[i * 64 + lane]; t2[i] = s2[i * 64 + lane]; t3[i] = s3[i * 64 + lane]; }
#pragma unroll
                    for (int i = 0; i < 4; ++i) { const int e = 4 * (i * 64 + lane), cc = e >> 6, pp = e & 63;
#pragma unroll
                        for (int k = 0; k < 4; ++k) { Cre[cc * 64 + ((pp + k + cc) & 63)] = t0[i][k]; Cim[cc * 64 + ((pp + k + cc) & 63)] = t1[i][k]; }
                        *(LAS f32x4*)(Bre + e) = t2[i]; *(LAS f32x4*)(Bim + e) = t3[i]; }
                }
                const float lre = A.in[I_LRE][g * 64 + lane], lim = A.in[I_LIM][g * 64 + lane]; const double dt = (double)expf(A.in[I_LDT][g]);
                float are, aim; cpow_n(lre, lim, dt, 1, are, aim);
                const float den = lre * lre + lim * lim, nr = are - 1.0f, ni = aim; const float cre = (nr * lre + ni * lim) / den, cim = (ni * lre - nr * lim) / den;
                float mr[5], mi[5];
                if (tb == 0) { mr[0] = 0.f; mi[0] = 0.f; mr[1] = cre; mi[1] = cim; }
                else { float pr, pi; cpow_n(lre, lim, dt, 5 * tb - 1, pr, pi); mr[0] = pr * cre - pi * cim; mi[0] = pr * cim + pi * cre; mr[1] = mr[0] * are - mi[0] * aim; mi[1] = mr[0] * aim + mi[0] * are; }
#pragma unroll
                for (int j = 2; j < 5; ++j) { mr[j] = mr[j - 1] * are - mi[j - 1] * aim; mi[j] = mr[j - 1] * aim + mi[j - 1] * are; }
                asm volatile("s_waitcnt lgkmcnt(0)" ::: "memory");
#pragma unroll 4
                for (int p = 0; p < 64; ++p) {
                    const float cr = Cre[c * 64 + ((p + c) & 63)], ci = Cim[c * 64 + ((p + c) & 63)];
                    const f32x4 br = *(const LAS f32x4*)(Bre + p * 16 + cq), bi = *(const LAS f32x4*)(Bim + p * 16 + cq);
#pragma unroll
                    for (int j = 0; j < 5; ++j) {
                        const float qr = __int_as_float(__builtin_amdgcn_readlane(__float_as_int(mr[j]), p)), qi = __int_as_float(__builtin_amdgcn_readlane(__float_as_int(mi[j]), p));
                        const float zr = cr * qr - ci * qi, zi = cr * qi + ci * qr;
#pragma unroll
                        for (int e = 0; e < 4; ++e) acc[j][e] += zr * br[e] - zi * bi[e];
                    }
                }
                asm volatile("s_waitcnt lgkmcnt(0)" ::: "memory");
            }
#pragma unroll
            for (int j = 0; j < 5; ++j) *(GAS v2u*)(Kt + (size_t)g * SSM_KERN_G + (5 * tb + j) * 256 + c * 16 + cq) = (v2u){pk2(acc[j][0], acc[j][1]), pk2(acc[j][2], acc[j][3])};
        }
    }
}
__device__ __forceinline__ float gelu_poly(float v) {
    const float av = fabsf(v), t = __builtin_amdgcn_rcpf(av * 0.2316418882f + 1.0f);
    float q = t * 0.5307027145f + (-0.7265760135f); q = q * t + 0.7107068705f; q = q * t + (-0.142248368f); q = q * t + 0.127414796f; q = q * t;
    const float e = __builtin_amdgcn_exp2f((v * v) * (-0.72134752044f));
    const float m = v * (q * e);
    return v < 0.f ? m : v - m;
}
typedef short ss_bf16x8 __attribute__((ext_vector_type(8)));
typedef float ss_f32x16 __attribute__((ext_vector_type(16)));
__device__ __forceinline__ void ssm_mfma_item(Frame& F, const Args& A, int item) {
    const int b = item >> 7, g = item & 127; int tid = F.tid; asm volatile("" : "+v"(tid));
    const int lane = tid & 63, wave = F.wave, r = lane & 31, hk = lane >> 5;
    LAS unsigned char* L = F.lds + RING_OFF;
    LAS unsigned char* UL = L + SSM_LDS_U; LAS unsigned char* KL = L + SSM_LDS_K; LAS float* SL = (LAS float*)(L + SSM_LDS_S); LAS unsigned char* HL = L + SSM_LDS_H;
    const bf16* ub = (const bf16*)(F.ws + WS_U); bf16* yg = (bf16*)(F.ws + WS_YG);
    const bf16* Wt = (const bf16*)(F.ws + WS_SW) + (size_t)g * 128 * 1024; const bf16* Vt = (const bf16*)(F.ws + WS_SVM) + (size_t)g * 1024 * 128; const bf16* Kt = (const bf16*)(F.ws + WS_SKERN) + (size_t)g * SSM_KERN_G;
    __syncthreads();
    float alr, ali;
    {
        v4u tu[8], tk[5];
#pragma unroll
        for (int q = 0; q < 8; ++q) { const int i = tid + q * 512, t = i >> 1, hf = i & 1; tu[q] = *(const GAS v4u*)(ub + ((size_t)(b * 128 + g) * SEQ) * 16 + (size_t)i * 8); }
#pragma unroll
        for (int q = 0; q < 5; ++q) { const int i = tid + q * 512; tk[q] = (i < 65 * 32) ? *(const GAS v4u*)(Kt + i * 8) : (v4u){0u, 0u, 0u, 0u}; }
        { const int p = tid & 63; const float lre = A.in[I_LRE][g * 64 + p], lim = A.in[I_LIM][g * 64 + p]; const double dt = (double)expf(A.in[I_LDT][g]); cpow_n(lre, lim, dt, 64, alr, ali); }
#pragma unroll
        for (int q = 0; q < 8; ++q) { const int i = tid + q * 512, t = i >> 1, hf = i & 1; *(LAS v4u*)(UL + (t >> 6) * SSM_UROW + (t & 63) * 32 + hf * 16) = tu[q]; }
#pragma unroll
        for (int q = 0; q < 5; ++q) { const int i = tid + q * 512; if (i < 65 * 32) *(LAS v4u*)(KL + i * 16) = tk[q]; }
    }
    __syncthreads();
    {
        ss_f32x16 acc = {};
        const int mt = wave & 3, kh = wave >> 2;
        const bf16* ap = Wt + (size_t)(mt * 32 + r) * 1024 + hk * 8 + kh * 512;
        const LAS unsigned char* bp = UL + r * SSM_UROW + hk * 16 + kh * 1024;
#pragma unroll 16
        for (int s = 0; s < 32; ++s) { const ss_bf16x8 a = *(const GAS ss_bf16x8*)(ap + s * 16); const ss_bf16x8 bb = *(const LAS ss_bf16x8*)(bp + s * 32);
            acc = __builtin_amdgcn_mfma_f32_32x32x16_bf16(a, bb, acc, 0, 0, 0); }
        if (kh == 0) {
#pragma unroll
            for (int rg = 0; rg < 16; ++rg) { const int row = mt * 32 + (rg & 3) + 8 * (rg >> 2) + 4 * hk; SL[row * 33 + r] = acc[rg]; } }
        __syncthreads();
        if (kh == 1) {
#pragma unroll
            for (int rg = 0; rg < 16; ++rg) { const int row = mt * 32 + (rg & 3) + 8 * (rg >> 2) + 4 * hk; SL[row * 33 + r] += acc[rg]; } }
    }
    __syncthreads();
    if (tid < 64) {
        const int p = tid;
        float sr[32], si[32];
#pragma unroll
        for (int n = 0; n < SSM_NCH; ++n) { sr[n] = SL[p * 33 + n]; si[n] = SL[(64 + p) * 33 + n]; }
        float hre = 0.f, him = 0.f;
#pragma unroll
        for (int n = 0; n < SSM_NCH; ++n) {
            *(LAS unsigned short*)(HL + n * 272 + p * 2) = (unsigned short)f2bf(hre); *(LAS unsigned short*)(HL + n * 272 + 128 + p * 2) = (unsigned short)f2bf(him);
            const float nre = alr * hre - ali * him + sr[n], nim = alr * him + ali * hre + si[n]; hre = nre; him = nim;
        }
    }
    __syncthreads();
    {
        ss_f32x16 acc[4] = {};
        int ti[4] = {wave, 15 - wave, 16 + wave, 31 - wave};
        int lane = tid & 63; asm volatile("" : "+v"(lane));
        const int r = lane & 31, hk = lane >> 5;
        const LAS unsigned char* bp = UL + r * SSM_UROW + hk * 16;
        const LAS unsigned char* kp = KL + ((lane >> 4) & 1) * 512 + (lane & 15) * 32 + hk * 16;
        const LAS unsigned char* hp = HL + r * 272 + hk * 16;
#pragma unroll
        for (int pr2 = 0; pr2 < 2; ++pr2) {
            ss_bf16x8 va[2][8];
#pragma unroll
            for (int qq = 0; qq < 2; ++qq)
#pragma unroll
                for (int ks = 0; ks < 8; ++ks) va[qq][ks] = *(const GAS ss_bf16x8*)(Vt + (size_t)(ti[2 * pr2 + qq] * 32 + r) * 128 + ks * 16 + hk * 8);
#pragma unroll
            for (int qq = 0; qq < 2; ++qq) { const int q = 2 * pr2 + qq; const int ns = 2 * ti[q] + 2; const LAS unsigned char* ka = kp + (2 * ti[q] + 1) * 512;
#pragma unroll 4
                for (int s = 0; s < ns; ++s) { const ss_bf16x8 bb = *(const LAS ss_bf16x8*)(bp + s * 32); const ss_bf16x8 a = *(const LAS ss_bf16x8*)(ka - s * 512);
                    acc[q] = __builtin_amdgcn_mfma_f32_32x32x16_bf16(a, bb, acc[q], 0, 0, 0); } }
#pragma unroll
            for (int ks = 0; ks < 8; ++ks) { const ss_bf16x8 hb = *(const LAS ss_bf16x8*)(hp + ks * 32);
#pragma unroll
                for (int qq = 0; qq < 2; ++qq) acc[2 * pr2 + qq] = __builtin_amdgcn_mfma_f32_32x32x16_bf16(va[qq][ks], hb, acc[2 * pr2 + qq], 0, 0, 0); }
        }
        __syncthreads();
#pragma unroll
        for (int q = 0; q < 4; ++q)
#pragma unroll
            for (int rg = 0; rg < 16; ++rg) { const int row = (rg & 3) + 8 * (rg >> 2) + 4 * hk; const int t = 2 * ti[q] + (row >> 4), c = row & 15;
                LAS unsigned short* up = (LAS unsigned short*)(UL + r * SSM_UROW + t * 32 + c * 2);
                const float y = acc[q][rg] + A.in[I_SD][g * 16 + c] * bf2f(*up);
                *up = (unsigned short)f2bf(gelu_poly(y)); }
    }
    __syncthreads();
    for (int i = tid; i < 4096; i += 512) { const int t = i >> 1, hf = i & 1; const v4u w = *(const LAS v4u*)(UL + (t >> 6) * SSM_UROW + (t & 63) * 32 + hf * 16);
        *(GAS v4u*)(yg + (size_t)(b * SEQ + t) * SW + g * 16 + hf * 8) = w;
        { const float q = pg8::FP8_SYG; v2u w8;
          w8.x = pg8::pk4_fp8(bflo(w.x) * q, bfhi(w.x) * q, bflo(w.y) * q, bfhi(w.y) * q); w8.y = pg8::pk4_fp8(bflo(w.z) * q, bfhi(w.z) * q, bflo(w.w) * q, bfhi(w.w) * q);
          *(GAS v2u*)(F.ws + WS_YG8 + (size_t)(b * SEQ + t) * SW + g * 16 + hf * 8) = w8; } }
}
constexpr size_t SLAB_BYTES = (size_t)PE * 128;
constexpr int NSLAB = DM / 128;
constexpr int NSLABU = DM / 256;
typedef __amdgpu_buffer_rsrc_t rsrc_t;
__device__ __forceinline__ rsrc_t mk_rsrc(const void* p, unsigned bytes) { return __builtin_amdgcn_make_buffer_rsrc((void*)p, (short)0, (int)bytes, 0x00020000); }
#ifndef GATHER_AUX
#define GATHER_AUX 0
#endif
__device__ __forceinline__ v4u bld(rsrc_t r, unsigned voff, unsigned soff) { return __builtin_amdgcn_raw_buffer_load_b128(r, (int)voff, (int)soff, GATHER_AUX); }
__device__ __forceinline__ float dpp_f(float v, const int ctrl) { return v; }
#define DPP_ADD(v, ctrl) (v) += __int_as_float(__builtin_amdgcn_mov_dpp(__float_as_int(v), (ctrl), 0xF, 0xF, true))
__device__ __forceinline__ unsigned nib4(float v) { const int q = (int)rintf(fminf(fmaxf(v, -7.f), 7.f)); return (unsigned)q & 15u; }
__device__ __forceinline__ unsigned pack_i8(float a, float b, float c, float d) {
    const int ia = (int)rintf(a), ib = (int)rintf(b), ic = (int)rintf(c), id = (int)rintf(d);
    return ((unsigned)ia & 0xffu) | (((unsigned)ib & 0xffu) << 8) | (((unsigned)ic & 0xffu) << 16) | ((unsigned)id << 24);
}
__device__ __forceinline__ void ptab_load(f32x4 (&v)[16], const float* src, int lane) {
    const GAS f32x4* p = (const GAS f32x4*)src + lane;
#pragma unroll
    for (int k = 0; k < 16; ++k) v[k] = p[64 * k];
}
__device__ __forceinline__ void ptab_quant(const f32x4 (&vin)[16], bool isv, const LAS f32x4* gf, LAS unsigned* ob, LAS float* sb, int lane) {
    f32x4 v[16]; float amax = 0.f;
#pragma unroll
    for (int k = 0; k < 16; ++k) { f32x4 t = vin[k]; if (!isv) t = t * gf[64 * k];
        v[k] = t; amax = fmaxf(amax, fmaxf(fmaxf(fabsf(t.x), fabsf(t.y)), fmaxf(fabsf(t.z), fabsf(t.w)))); }
    amax = wave_max(amax);
    const float qmax = isv ? 6.0f : 7.0f;
    const float scale = amax > 0.f ? amax / qmax : 1.0f, inv = 1.0f / scale;
#pragma unroll
    for (int k = 0; k < 16; ++k) { const f32x4 t = v[k] * inv; unsigned hw;
        if (isv) { unsigned d = 0u; d = __builtin_amdgcn_cvt_scalef32_pk_fp4_f32(d, fminf(fmaxf(t.x, -6.f), 6.f), fminf(fmaxf(t.y, -6.f), 6.f), 1.0f, 0);
            d = __builtin_amdgcn_cvt_scalef32_pk_fp4_f32(d, fminf(fmaxf(t.z, -6.f), 6.f), fminf(fmaxf(t.w, -6.f), 6.f), 1.0f, 1); hw = d & 0xffffu; }
        else hw = nib4(t.x) | (nib4(t.y) << 4) | (nib4(t.z) << 8) | (nib4(t.w) << 12);
        const unsigned other = (unsigned)__builtin_amdgcn_mov_dpp((int)hw, 0xB1, 0xF, 0xF, true);
        if ((lane & 1) == 0) ob[k * 32 + (lane >> 1)] = hw | (other << 16); }
    if (lane == 0) sb[0] = scale;
}
__device__ __forceinline__ void peer_tables_slab(Frame& F, const Args& A) {
    const int gw = F.vcu * NWAVES + F.wave, NGW = F.G * NWAVES, lane = F.lane;
    unsigned char* U8 = F.ws + WS_U8; unsigned char* V8 = F.ws + WS_V8; float* SU = (float*)(F.ws + WS_SU); float* SV = (float*)(F.ws + WS_SV);
    LAS unsigned* OB = (LAS unsigned*)(F.lds + RING_OFF) + F.wave * 2304;
    LAS float* SB = (LAS float*)(OB + 2048);
    __syncthreads();
    LAS f32x4* GL = (LAS f32x4*)(F.lds + RING_OFF + 81920);
    for (int i = F.tid; i < DM / 4; i += NWAVES * 64) GL[i] = ((const GAS f32x4*)A.in[I_GFFN])[i];
    __syncthreads();
    const LAS f32x4* gf = GL + lane;
    if (gw >= 2 * PE) return;
    const int ntot = (2 * PE - gw + NGW - 1) / NGW;
#define ROWID(k) (gw + ((k) < ntot ? (k) : ntot - 1) * NGW)
#define ROWSRC(rr) (((rr) >= PE ? A.in[I_PV] : A.in[I_PU]) + (size_t)((rr) >= PE ? (rr) - PE : (rr)) * DM)
    f32x4 va[16], vb[16];
    ptab_load(va, ROWSRC(ROWID(0)), lane);
    for (int kb = 0; kb < ntot; kb += 4) {
        ptab_load(vb, ROWSRC(ROWID(kb + 1)), lane); ptab_quant(va, ROWID(kb) >= PE, gf, OB, SB, lane);
        ptab_load(va, ROWSRC(ROWID(kb + 2)), lane); ptab_quant(vb, ROWID(kb + 1) >= PE, gf, OB + 512, SB + 1, lane);
        ptab_load(vb, ROWSRC(ROWID(kb + 3)), lane); ptab_quant(va, ROWID(kb + 2) >= PE, gf, OB + 1024, SB + 2, lane);
        ptab_load(va, ROWSRC(ROWID(kb + 4)), lane); ptab_quant(vb, ROWID(kb + 3) >= PE, gf, OB + 1536, SB + 3, lane);
        asm volatile("s_waitcnt lgkmcnt(0)" ::: "memory");
#pragma unroll
        for (int i = 0; i < 4; ++i) { if (kb + i < ntot) { const int rr = ROWID(kb + i); const bool isv = rr >= PE; const int e = isv ? rr - PE : rr;
                unsigned char* dst = (isv ? V8 : U8) + (size_t)e * 128;
#pragma unroll
                for (int q = 0; q < 2; ++q) { const int d4 = q * 64 + lane; *(GAS v4u*)(dst + (size_t)(d4 >> 3) * SLAB_BYTES + (d4 & 7) * 16) = *(const LAS v4u*)(OB + i * 512 + d4 * 4); }
                if (lane == 0) { if (isv) SV[e] = SB[i]; else SU[e] = SB[i]; } } }
        asm volatile("s_waitcnt lgkmcnt(0)" ::: "memory");
    }
#undef ROWID
#undef ROWSRC
}
__device__ __forceinline__ void peer_xq_phase(Frame& F) {
    const int gw = F.vcu * NWAVES + F.wave, NGW = F.G * NWAVES, lane = F.lane;
    const bf16* x1 = (const bf16*)(F.ws + WS_X1BF); unsigned* XH = (unsigned*)(F.ws + WS_XH); unsigned* XL = (unsigned*)(F.ws + WS_XL); float* XS = (float*)(F.ws + WS_XS);
    for (int tok = gw; tok < T; tok += NGW) {
        const GAS v4u* src = (const GAS v4u*)(x1 + (size_t)tok * DM) + lane;
        v4u v[8]; float amax = 0.f;
#pragma unroll
        for (int k = 0; k < 8; ++k) { const v4u t = src[64 * k]; v[k] = t;
#pragma unroll
            for (int e = 0; e < 4; ++e) amax = fmaxf(amax, fmaxf(fabsf(bflo(t[e])), fabsf(bfhi(t[e])))); }
        amax = wave_max(amax);
        const float qs = amax > 0.f ? 119.0f / amax : 0.f;
#pragma unroll
        for (int k = 0; k < 8; ++k) { unsigned hh = 0u, ll = 0u;
#pragma unroll
            for (int e = 0; e < 8; ++e) { const float xv = (e & 1) ? bfhi(v[k][e >> 1]) : bflo(v[k][e >> 1]); const int q = (int)rintf(xv * qs); const int l = ((q & 15) ^ 8) - 8; const int h = (q - l) >> 4;
                ll |= ((unsigned)l & 15u) << (4 * e); hh |= ((unsigned)h & 15u) << (4 * e); }
            XH[(size_t)tok * 512 + 64 * k + lane] = hh; XL[(size_t)tok * 512 + 64 * k + lane] = ll; }
        if (lane == 0) XS[tok] = amax * (1.0f / 119.0f);
    }
}
#define DPPI(v, ctrl) __builtin_amdgcn_mov_dpp((v), (ctrl), 0xF, 0xF, true)
__device__ __forceinline__ void pu_issue(v4u (&rows)[16], v4u& xh, v4u& xl, const v4u (&ids)[4], rsrc_t rT, unsigned j16, const unsigned* xhp, const unsigned* xlp) {
#pragma unroll
    for (int i = 0; i < 16; ++i) rows[i] = bld(rT, ids[i >> 2][i & 3] * 128u + j16, 0);
    xh = *(const GAS v4u*)xhp; xl = *(const GAS v4u*)xlp;
}
__device__ __forceinline__ void pu_compute(const v4u (&rows)[16], const v4u xh, const v4u xl, float deq, int j, LAS float* dstbase, bool accum) {
    int v[16];
#pragma unroll
    for (int i = 0; i < 16; ++i) { int ah = 0, al = 0;
#pragma unroll
        for (int q = 0; q < 4; ++q) { ah = __builtin_amdgcn_sdot8((int)rows[i][q], (int)xh[q], ah, false); al = __builtin_amdgcn_sdot8((int)rows[i][q], (int)xl[q], al, false); }
        v[i] = (ah << 4) + al; }
    const bool L2 = (j & 4) != 0, L0 = (j & 1) != 0, L1 = (j & 2) != 0;
    int w[8], u[4], z[2];
#pragma unroll
    for (int r = 0; r < 8; ++r) { const int keep = L2 ? v[r + 8] : v[r], send = L2 ? v[r] : v[r + 8]; w[r] = keep + DPPI(send, 0x141); }
#pragma unroll
    for (int r = 0; r < 4; ++r) { const int keep = L0 ? w[r + 4] : w[r], send = L0 ? w[r] : w[r + 4]; u[r] = keep + DPPI(send, 0xB1); }
#pragma unroll
    for (int r = 0; r < 2; ++r) { const int keep = L1 ? u[r + 2] : u[r], send = L1 ? u[r] : u[r + 2]; z[r] = keep + DPPI(send, 0x4E); }
    const int rbase = 8 * (j >> 2) + 4 * (j & 1) + 2 * ((j >> 1) & 1);
    f32x2 res = {(float)z[0] * deq, (float)z[1] * deq};
    if (accum) res += *(const LAS f32x2*)(dstbase + rbase);
    *(LAS f32x2*)(dstbase + rbase) = res;
}
__device__ __forceinline__ void pu_ids(v4u (&ids)[4], const int* ep) {
    const GAS v4u* ip = (const GAS v4u*)ep; ids[0] = ip[0]; ids[1] = ip[1]; ids[2] = ip[2]; ids[3] = ip[3];
}
__device__ __forceinline__ void peer_u_phase(Frame& F) {
    const int nx = F.G / 8, xcd = F.vcu / nx, c = F.vcu % nx, gwl = c * NWAVES + F.wave, nwl = nx * NWAVES, lane = F.lane, j = lane & 7, grp = lane >> 3;
    const int* ex = (const int*)(F.ws + WS_EXP) + grp * 16; float* part = (float*)(F.ws + WS_PART);
    const unsigned* XH = (const unsigned*)(F.ws + WS_XH) + j * 4; const unsigned* XL = (const unsigned*)(F.ws + WS_XL) + j * 4; const float* XS = (const float*)(F.ws + WS_XS);
    LAS float* PL = (LAS float*)(F.lds + RING_OFF) + F.wave * 4096;
    const unsigned j16 = (unsigned)j * 16u;
    if (gwl >= T) return;
    const int ntot = (T - gwl + nwl - 1) / nwl;
    for (int kb = 0; kb < ntot; kb += 32) {
        const int n = (ntot - kb) < 32 ? (ntot - kb) : 32;
#define TOK(k) (gwl + (kb + ((k) < n ? (k) : n - 1)) * nwl)
        for (int si = 0; si < NSLABU / 8; ++si) {
            const int slab = xcd * (NSLABU / 8) + si; const bool accum = si > 0;
            const rsrc_t rT = mk_rsrc(F.ws + WS_U8 + (size_t)slab * SLAB_BYTES, (unsigned)SLAB_BYTES);
            v4u id0[4], id1[4], rowA[16], rowB[16], hA, lA, hB, lB;
            pu_ids(id0, ex + (size_t)TOK(0) * PSEL); pu_ids(id1, ex + (size_t)TOK(1) * PSEL);
            pu_issue(rowA, hA, lA, id0, rT, j16, XH + (size_t)TOK(0) * 512 + slab * 32, XL + (size_t)TOK(0) * 512 + slab * 32);
            for (int k = 0; k < n; k += 2) {
                pu_ids(id0, ex + (size_t)TOK(k + 2) * PSEL);
                pu_issue(rowB, hB, lB, id1, rT, j16, XH + (size_t)TOK(k + 1) * 512 + slab * 32, XL + (size_t)TOK(k + 1) * 512 + slab * 32);
                pu_compute(rowA, hA, lA, XS[TOK(k)], j, PL + k * 128 + grp * 16, accum);
                pu_ids(id1, ex + (size_t)TOK(k + 3) * PSEL);
                pu_issue(rowA, hA, lA, id0, rT, j16, XH + (size_t)TOK(k + 2) * 512 + slab * 32, XL + (size_t)TOK(k + 2) * 512 + slab * 32);
                pu_compute(rowB, hB, lB, XS[TOK(k + 1)], j, PL + (k + 1) * 128 + grp * 16, accum);
            }
        }
        asm volatile("s_waitcnt lgkmcnt(0)" ::: "memory");
        for (int k = 0; k < n; ++k) { const f32x2 v = *(const LAS f32x2*)(PL + k * 128 + lane * 2); *(GAS f32x2*)(part + ((size_t)xcd * T + TOK(k)) * PSEL + lane * 2) = v; }
        asm volatile("s_waitcnt lgkmcnt(0)" ::: "memory");
#undef TOK
    }
}
__device__ __forceinline__ void pc_emit(unsigned char* cb, float x, int s) {
    const unsigned h = (unsigned)__builtin_amdgcn_cvt_pk_fp8_f32(x, 0.f, 0, false) & 0xffu;
    const int hh = (s >> 5) & 1, i = s & 15, q = 2 * (s >> 6) + ((s >> 4) & 1);
    cb[(hh * 16 + i) * 4 + q] = (unsigned char)h;
}
__device__ __forceinline__ void peer_combine_phase(Frame& F) {
    const int gw = F.vcu * NWAVES + F.wave, NGW = F.G * NWAVES, lane = F.lane;
    const int* ex = (const int*)(F.ws + WS_EXP); const float* gt = (const float*)(F.ws + WS_GATE); const float* part = (const float*)(F.ws + WS_PART);
    const float* SU = (const float*)(F.ws + WS_SU); const float* SV = (const float*)(F.ws + WS_SV);
    unsigned char* CB = F.ws + WS_CB; float* TS = (float*)(F.ws + WS_TS);
    for (int tok = gw; tok < T; tok += NGW) {
        const float r1 = 1.0f / sqrtf(((const float*)(F.ctl + CW_SSQ1))[tok] * (1.0f / DM) + RMS_EPS);
        float s0 = 0.f, s1 = 0.f;
#pragma unroll 8
        for (int s = 0; s < 8; ++s) { const float* pp = part + ((size_t)s * T + tok) * PSEL; s0 += pp[lane]; s1 += pp[64 + lane]; }
        const int e0 = ex[(size_t)tok * PSEL + lane], e1 = ex[(size_t)tok * PSEL + 64 + lane];
        const float g0 = gt[(size_t)tok * PSEL + lane], g1 = gt[(size_t)tok * PSEL + 64 + lane];
        const float c0 = g0 * gelu_erf(s0 * SU[e0] * r1) * SV[e0], c1 = g1 * gelu_erf(s1 * SU[e1] * r1) * SV[e1];
        const float cmax = wave_max(fmaxf(fabsf(c0), fabsf(c1)));
        const float sc = cmax > 0.f ? 224.0f / cmax : 0.f;
        if (lane == 0) TS[tok] = cmax * (1.0f / 224.0f);
        pc_emit(CB + (size_t)tok * 128, c0 * sc, lane); pc_emit(CB + (size_t)tok * 128, c1 * sc, 64 + lane);
    }
}
typedef int v8i __attribute__((ext_vector_type(8)));
typedef int v4i_ __attribute__((ext_vector_type(4)));
__device__ __forceinline__ void pv_ids(v4u (&ids)[4], const int* ep) {
    const GAS v4u* ip = (const GAS v4u*)ep; ids[0] = ip[0]; ids[1] = ip[1]; ids[2] = ip[2]; ids[3] = ip[3];
}
__device__ __forceinline__ void pv_issue(v4u (&rows)[16], v4u (&w)[4], float& ts, const v4u (&ids)[4], rsrc_t rT, unsigned j16, const unsigned* cbp, const float* tsp) {
#pragma unroll
    for (int i = 0; i < 16; ++i) rows[i] = bld(rT, ids[i >> 2][i & 3] * 128u + j16, 0);
    const GAS v4u* cq = (const GAS v4u*)cbp; w[0] = cq[0]; w[1] = cq[1]; w[2] = cq[2]; w[3] = cq[3]; ts = *tsp;
}
__device__ __forceinline__ void pv_compute(const v4u (&rows)[16], const v4u (&w)[4], float ts, const unsigned (&sel)[8], LAS v2u* ol) {
    f32x4 d0 = {0.f, 0.f, 0.f, 0.f}, d1 = {0.f, 0.f, 0.f, 0.f};
#pragma unroll
    for (int i = 0; i < 16; ++i) {
        const auto s02 = __builtin_amdgcn_permlane16_swap(rows[i][0], rows[i][2], false, false); const auto s13 = __builtin_amdgcn_permlane16_swap(rows[i][1], rows[i][3], false, false);
        const unsigned t0 = s02[0], t2 = s02[1], t1 = s13[0], t3 = s13[1];
        v8i b = {0, 0, 0, 0, 0, 0, 0, 0};
        b[0] = __builtin_amdgcn_update_dpp((int)t0, (int)t1, 0x128, 0xF, 0xC, false); b[1] = __builtin_amdgcn_update_dpp((int)t1, (int)t0, 0x128, 0xF, 0x3, false);
        b[2] = __builtin_amdgcn_update_dpp((int)t2, (int)t3, 0x128, 0xF, 0xC, false); b[3] = __builtin_amdgcn_update_dpp((int)t3, (int)t2, 0x128, 0xF, 0x3, false);
        const unsigned W = w[i >> 2][i & 3];
        v8i a;
#pragma unroll
        for (int q = 0; q < 8; ++q) a[q] = (int)__builtin_amdgcn_perm(W, W, sel[q]);
        if (i & 1) d1 = __builtin_amdgcn_mfma_scale_f32_16x16x128_f8f6f4(a, b, d1, 0, 4, 0, 0x7f7f7f7f, 0, 0x7f7f7f7f);
        else d0 = __builtin_amdgcn_mfma_scale_f32_16x16x128_f8f6f4(a, b, d0, 0, 4, 0, 0x7f7f7f7f, 0, 0x7f7f7f7f);
    }
    const f32x4 o = (d0 + d1) * ts;
    *ol = (v2u){pk2(o[0], o[1]), pk2(o[2], o[3])};
}
__device__ __forceinline__ void peer_v_phase(Frame& F) {
    const int nx = F.G / 8, xcd = F.vcu / nx, c = F.vcu % nx, gwl = c * NWAVES + F.wave, nwl = nx * NWAVES, lane = F.lane, j = lane & 7, grp = lane >> 3;
    const int m = lane & 15, kq = lane >> 4;
    const int* ex = (const int*)(F.ws + WS_EXP) + grp * 16; const unsigned* cbp = (const unsigned*)(F.ws + WS_CB) + (kq & 1) * 16; const float* TS = (const float*)(F.ws + WS_TS);
    bf16* peer = (bf16*)(F.ws + WS_X2B);
    LAS unsigned char* OL = F.lds + RING_OFF + F.wave * 16384;
    const unsigned j16 = (unsigned)j * 16u;
    unsigned sel[8];
#pragma unroll
    for (int v = 0; v < 4; ++v) { const unsigned sb = (0x0c0c0c0cu & ~(0xffu << (8 * (m & 3)))) | ((unsigned)v << (8 * (m & 3))); const bool par = ((m >> 2) & 1) != 0, valid = (kq >> 1) == (m >> 3);
        sel[2 * v] = (par || !valid) ? 0x0c0c0c0cu : sb; sel[2 * v + 1] = (par && valid) ? sb : 0x0c0c0c0cu; }
    LAS v2u* olp = (LAS v2u*)(OL + (32 * (lane & 7) + 16 * (lane >> 5) + 8 * ((lane >> 3) & 1) + 4 * ((lane >> 4) & 1)) * 2);
    if (gwl >= T) return;
    const int ntot = (T - gwl + nwl - 1) / nwl;
    for (int si = 0; si < NSLABU / 8; ++si) {
        const int slab = xcd * (NSLABU / 8) + si;
        const rsrc_t rT = mk_rsrc(F.ws + WS_V8 + (size_t)slab * SLAB_BYTES, (unsigned)SLAB_BYTES);
        for (int kb = 0; kb < ntot; kb += 32) {
            const int n = (ntot - kb) < 32 ? (ntot - kb) : 32;
#define TOK(k) (gwl + (kb + ((k) < n ? (k) : n - 1)) * nwl)
            v4u id0[4], id1[4], rowA[16], rowB[16], wA[4], wB[4]; float tA, tB;
            pv_ids(id0, ex + (size_t)TOK(0) * PSEL); pv_ids(id1, ex + (size_t)TOK(1) * PSEL);
            pv_issue(rowA, wA, tA, id0, rT, j16, cbp + (size_t)TOK(0) * 32, TS + TOK(0));
            for (int k = 0; k < n; k += 2) {
                pv_ids(id0, ex + (size_t)TOK(k + 2) * PSEL);
                pv_issue(rowB, wB, tB, id1, rT, j16, cbp + (size_t)TOK(k + 1) * 32, TS + TOK(k + 1));
                __builtin_amdgcn_sched_barrier(0);
                pv_compute(rowA, wA, tA, sel, olp + k * 64);
                __builtin_amdgcn_sched_barrier(0);
                pv_ids(id1, ex + (size_t)TOK(k + 3) * PSEL);
                pv_issue(rowA, wA, tA, id0, rT, j16, cbp + (size_t)TOK(k + 2) * 32, TS + TOK(k + 2));
                __builtin_amdgcn_sched_barrier(0);
                pv_compute(rowB, wB, tB, sel, olp + (k + 1) * 64);
                __builtin_amdgcn_sched_barrier(0);
            }
            asm volatile("s_waitcnt lgkmcnt(0)" ::: "memory");
            for (int k = 0; k < n; ++k) { const v2u o = *(const LAS v2u*)(OL + k * 512 + lane * 8); *(GAS v2u*)(peer + (size_t)TOK(k) * DM + slab * 256 + lane * 4) = o; }
            asm volatile("s_waitcnt lgkmcnt(0)" ::: "memory");
#undef TOK
        }
    }
}
__device__ __forceinline__ void final_norm_phase(Frame& F, const Args& A) {
    const int gw = F.vcu * NWAVES + F.wave, NGW = F.G * NWAVES, lane = F.lane;
    const float* gfin = A.in[I_GFIN]; const bf16* x1 = (const bf16*)(F.ws + WS_X1BF); const bf16* peer = (const bf16*)(F.ws + WS_X2B);
    f32x4 ga[8], gb[8];
    { const GAS f32x4* gq = (const GAS f32x4*)gfin + 2 * lane;
#pragma unroll
      for (int k = 0; k < 8; ++k) { ga[k] = gq[128 * k]; gb[k] = gq[128 * k + 1]; } }
    for (int tok = gw; tok < T; tok += NGW) {
        const GAS v4u* p1 = (const GAS v4u*)(x1 + (size_t)tok * DM) + lane; const GAS v4u* p2 = (const GAS v4u*)(peer + (size_t)tok * DM) + lane;
        GAS f32x4* o = (GAS f32x4*)(F.out + (size_t)tok * DM) + 2 * lane;
        f32x4 xa[8], xb[8]; float ss = 0.f;
#pragma unroll
        for (int k = 0; k < 8; ++k) { const v4u a = p1[64 * k], b = p2[64 * k];
            xa[k] = (f32x4){bflo(a.x) + bflo(b.x), bfhi(a.x) + bfhi(b.x), bflo(a.y) + bflo(b.y), bfhi(a.y) + bfhi(b.y)};
            xb[k] = (f32x4){bflo(a.z) + bflo(b.z), bfhi(a.z) + bfhi(b.z), bflo(a.w) + bflo(b.w), bfhi(a.w) + bfhi(b.w)};
            ss += (xa[k].x * xa[k].x + xa[k].y * xa[k].y) + (xa[k].z * xa[k].z + xa[k].w * xa[k].w) + (xb[k].x * xb[k].x + xb[k].y * xb[k].y) + (xb[k].z * xb[k].z + xb[k].w * xb[k].w); }
        ss = wave_sum(ss);
        const float rf = 1.0f / sqrtf(ss * (1.0f / DM) + RMS_EPS);
#pragma unroll
        for (int k = 0; k < 8; ++k) { o[128 * k] = xa[k] * rf * ga[k]; o[128 * k + 1] = xb[k] * rf * gb[k]; }
    }
}
#ifndef MK_N_LAUNCHES
#define MK_N_LAUNCHES 1
#endif
constexpr int N_PHASES = 13;
__global__ void __launch_bounds__(NWAVES * 64, 2) fwd_kernel(Args args) {
    extern __shared__ __attribute__((aligned(16))) unsigned char lds[];
    Frame F;
    F.lds = (LAS unsigned char*)lds;
    F.MISC = (volatile LAS unsigned*)(F.lds + MISC_OFF);
    F.tid = threadIdx.x; F.lane = F.tid & 63; F.wave = __builtin_amdgcn_readfirstlane(F.tid >> 6);
    F.G = gridDim.x; { const int bx = blockIdx.x; F.vcu = (F.G % 8 == 0) ? (bx % 8) * (F.G / 8) + bx / 8 : bx; }
    F.ws = args.ws; F.out = args.out;
    F.ctl = (gu32*)(args.ws + WS_CTL);
    for (int u = F.tid; u < (LDS_BYTES - LDSCTL_OFF) / 4; u += NWAVES * 64) ((LAS unsigned*)(F.lds + LDSCTL_OFF))[u] = 0u;
    __syncthreads();
    const int lo = args.ph_lo, hi = args.ph_hi;
    const bool multi = (hi - lo) > 1;
    XcdBarrier bar; bar.bar = (unsigned*)(F.ctl + CW_BAR); bar.x = 0; bar.st = nullptr;
    if (multi) bar = xcd_barrier_post((unsigned*)(F.ctl + CW_BAR), F.MISC + 8);
#define IN(k) (lo <= (k) && (k) < hi)
#define BOTH(k) (IN(k) && IN((k) + 1))
#define GRID_BAR() xcd_barrier(bar)
#ifndef PROBE_GEMM
#define PROBE_GEMM 0
#endif
#ifndef PROBE_MASK
#define PROBE_MASK 0
#endif
#define REP(k) for (int rep_ = 0; rep_ < 1 + ((PROBE_MASK >> (k)) & 1); ++rep_)

    if (IN(0)) {
#ifndef P0_MASK
#define P0_MASK 0
#endif
#ifndef P0_ORDER_A
#define P0_ORDER_A 1
#endif
        for (int r0_ = 0; r0_ < 1 + (P0_MASK & 1); ++r0_) p0_prologue(F, args, P0_ORDER_A);
        for (int r0_ = 0; r0_ < 1 + ((P0_MASK >> 1) & 1); ++r0_) peer_tables_slab(F, args);
#if SSM_MFMA
        for (int r0_ = 0; r0_ < 1 + ((P0_MASK >> 2) & 1); ++r0_) ssm_tables(F, args);
#endif
        if (P0_ORDER_A != 7) { __syncthreads(); p0_prologue(F, args, 7 & ~P0_ORDER_A); }
        if (BOTH(0)) GRID_BAR(); }

    if (IN(1)) { REP(1) {
        { pg8::Gemm g{(const pg8::bf16_t*)(F.ws + WS_H), (const pg8::bf16_t*)(F.ws + WS_WIN), T, NSPLIT, DM}; pg8::StaticOrder S; S.init(T, NSPLIT, F.G, (int)blockIdx.x);
          pg8::EpiInProj E{(pg8::bf16_t*)(F.ws + WS_QKV), (pg8::bf16_t*)(F.ws + WS_U), 0, 1.0f};
          pg8::gemm_phase<pg8::EpiInProj, pg8::StaticOrder, true, true>(F.lds + RING_OFF, g, S, E);
#if PROBE_GEMM || defined(PROBE_INBF)
          pg8::gemm_phase<pg8::EpiInProj, pg8::StaticOrder, true, true>(F.lds + RING_OFF, g, S, E);
#endif
        }
        { pg8::Gemm g{(const pg8::bf16_t*)(F.ws + WS_H8), (const pg8::bf16_t*)(F.ws + WS_WIN8), T, NIN - NSPLIT, DM}; pg8::StaticOrder S; S.init(T, NIN - NSPLIT, F.G, (int)blockIdx.x);
          pg8::EpiInProj E{(pg8::bf16_t*)(F.ws + WS_QKV), (pg8::bf16_t*)(F.ws + WS_U), NSPLIT / 256, 1.0f / (pg8::FP8_SH * pg8::FP8_SWI)};
          pg8::gemm_phase<pg8::EpiInProj, pg8::StaticOrder, true, true, false, true>(F.lds + RING_OFF, g, S, E);
#if PROBE_GEMM || defined(PROBE_INFP8)
          pg8::gemm_phase<pg8::EpiInProj, pg8::StaticOrder, true, true, false, true>(F.lds + RING_OFF, g, S, E);
#endif
        }
        }
        if (BOTH(1)) GRID_BAR();
    }
    if (IN(2)) { REP(2) {
#if SSM_MFMA
        if (F.G == 256) {
            const int xcd = F.vcu >> 5, c = F.vcu & 31;
            for (int kk = 0; kk < 2; ++kk) ssm_mfma_item(F, args, ((c >> 4) + 2 * kk) * SG + 16 * xcd + (c & 15));
        } else for (int it = blockIdx.x; it < BATCH * SG; it += F.G) ssm_mfma_item(F, args, it);
#else
        for (int it = blockIdx.x; it < BATCH * SG; it += F.G) ssm_naive_item(F, args, it);
#endif
        __syncthreads();
        for (int it = blockIdx.x; it < BATCH * NH * MOBA_NB; it += F.G) kmean_item(F, it); __syncthreads(); }
        if (BOTH(2)) GRID_BAR();
    }
    if (IN(3)) { REP(3) {
        __syncthreads();
#if ATTN_MFMA
        attn_mfma_phase(F, lds);
#else
        for (int it = blockIdx.x; it < BATCH * NH * (SEQ / 8); it += F.G) attn_naive_item(F, it);
#endif
        }
    }
    if (IN(4)) { REP(4) {
        __syncthreads();
        pg8::Gemm g{(const pg8::bf16_t*)(F.ws + WS_YG8), (const pg8::bf16_t*)(F.ws + WS_WGLU), T, SW, SW}; pg8::StaticOrder S; S.init(T, SW, F.G, (int)blockIdx.x);
        pg8::EpiGlu E{(const pg8::bf16_t*)(F.ws + WS_YG), (pg8::bf16_t*)(F.ws + WS_YCAT), (float*)(F.ctl + CW_SSQS)};
        pg8::gemm_phase<pg8::EpiGlu, pg8::StaticOrder, true, true, false, true>(F.lds + RING_OFF, g, S, E);
#if PROBE_GEMM
        pg8::gemm_phase<pg8::EpiGlu, pg8::StaticOrder, true, true, false, true>(F.lds + RING_OFF, g, S, E);
#endif
        }
        if (BOTH(4)) GRID_BAR();
    }
    if (IN(6)) { REP(6) {
        pg8::Gemm g{(const pg8::bf16_t*)(F.ws + WS_YCAT), (const pg8::bf16_t*)(F.ws + WS_WOUT), T, DM, DM}; pg8::StaticOrder S; S.init(T, DM, F.G, (int)blockIdx.x);
        pg8::EpiOutProj E{args.in[I_X], (pg8::bf16_t*)(F.ws + WS_X1BF), rep_ ? nullptr : (float*)(F.ctl + CW_SSQ1), (const float*)(F.ctl + CW_SSQAT), (const float*)(F.ctl + CW_SSQS), F.ws + WS_X1F8};
        pg8::gemm_phase<pg8::EpiOutProj, pg8::StaticOrder, true, true, true, true>(F.lds + RING_OFF, g, S, E);
#if PROBE_GEMM
        { pg8::EpiOutProj E2{args.in[I_X], (pg8::bf16_t*)(F.ws + WS_X1BF), nullptr, (const float*)(F.ctl + CW_SSQAT), (const float*)(F.ctl + CW_SSQS), F.ws + WS_X1F8}; pg8::gemm_phase<pg8::EpiOutProj, pg8::StaticOrder, true, true, true, true>(F.lds + RING_OFF, g, S, E2); }
#endif
        }
        if (BOTH(6)) GRID_BAR();
    }
    if (IN(7)) {
        pg8::Gemm g{(const pg8::bf16_t*)(F.ws + WS_X1F8), (const pg8::bf16_t*)(F.ws + WS_WQ), T, 2048, DM}; pg8::StaticOrder S; S.init(T, 2048, F.G, (int)blockIdx.x);
        pg8::EpiPeerQ E{(const float*)(F.ctl + CW_SSQ1), (pg8::bf16_t*)(F.ws + WS_QP)};
        pg8::gemm_phase<pg8::EpiPeerQ, pg8::StaticOrder, true, true, false, true>(F.lds + RING_OFF, g, S, E);
#if PROBE_GEMM
        pg8::gemm_phase<pg8::EpiPeerQ, pg8::StaticOrder, true, true, false, true>(F.lds + RING_OFF, g, S, E);
#endif
        const bool fused78 = (F.G == (T / 256) * (2048 / 256)) && IN(8);
        if (fused78) {
            pg8::Unit u; S.next(0, u);
            asm volatile("s_waitcnt vmcnt(0)" ::: "memory"); __syncthreads();
            topk_mfma_item(F, (2 * u.pm) * PH + u.pn); topk_mfma_item(F, (2 * u.pm + 1) * PH + u.pn);
            peer_xq_phase(F);
            if (BOTH(8)) GRID_BAR();
        } else if (BOTH(7)) GRID_BAR();
    }
    if (IN(8) && !(IN(7) && F.G == (T / 256) * (2048 / 256))) { REP(8) {
        __syncthreads();
        for (int it = F.vcu; it < (T / 128) * PH; it += F.G) topk_mfma_item(F, it);
        }
        peer_xq_phase(F);
        if (BOTH(8)) GRID_BAR();
    }
    if (IN(9)) { REP(9) { peer_u_phase(F); } if (BOTH(9)) GRID_BAR(); }
    if (IN(10)) { REP(10) { peer_combine_phase(F); } if (BOTH(10)) GRID_BAR(); }
    if (IN(11)) { REP(11) { __syncthreads(); peer_v_phase(F); } if (BOTH(11)) GRID_BAR(); }
    if (IN(12)) { REP(12) { final_norm_phase(F, args); } }
#undef IN
#undef BOTH
#undef GRID_BAR
}

extern "C" void kernel_launch(void* const* d_in, const int* in_sizes, int n_in, void* d_out, int out_size, void* d_ws, size_t ws_size, hipStream_t stream) {
    static int grid = 0;
    if (grid == 0) {
        if (n_in != 23 || in_sizes[0] != T * DM || out_size != T * DM || ws_size < WS_END) { fprintf(stderr, "kernel_launch: unexpected shapes (n_in %d, in0 %d, out %d, ws %zu)\n", n_in, n_in > 0 ? in_sizes[0] : -1, out_size, ws_size); grid = -1; return; }
        int dev = 0, cus = 0, per_cu = 0;
        if (hipGetDevice(&dev) != hipSuccess || hipDeviceGetAttribute(&cus, hipDeviceAttributeMultiprocessorCount, dev) != hipSuccess) { grid = -1; return; }
        if (hipFuncSetAttribute((const void*)fwd_kernel, hipFuncAttributeMaxDynamicSharedMemorySize, LDS_BYTES) != hipSuccess) { fprintf(stderr, "kernel_launch: hipFuncSetAttribute failed\n"); grid = -1; return; }
        if (hipOccupancyMaxActiveBlocksPerMultiprocessor(&per_cu, (const void*)fwd_kernel, NWAVES * 64, LDS_BYTES) != hipSuccess || per_cu < 1)
            fprintf(stderr, "kernel_launch: occupancy query reports %d workgroups per CU\n", per_cu);
        (void)hipGetLastError();
        grid = cus;
    }
    if (grid < 0) return;
    if (hipMemsetAsync((char*)d_ws + WS_CTL, 0, CTL_ZERO_BYTES, stream) != hipSuccess) return;
    Args a{};
    for (int i = 0; i < 23; ++i) a.in[i] = (const float*)d_in[i];
    a.out = (float*)d_out; a.ws = (unsigned char*)d_ws;
    if (MK_N_LAUNCHES == 1) { a.ph_lo = 0; a.ph_hi = N_PHASES; hipLaunchKernelGGL(fwd_kernel, dim3(grid), dim3(NWAVES * 64), LDS_BYTES, stream, a); }
    else for (int p = 0; p < N_PHASES; ++p) { a.ph_lo = p; a.ph_hi = p + 1; hipLaunchKernelGGL(fwd_kernel, dim3(grid), dim3(NWAVES * 64), LDS_BYTES, stream, a); }
}
```

```cpp
#include <hip/hip_runtime.h>
#include <cstdio>
#include <cstdint>
#define MK_N_LAUNCHES 1
#define ATTN_MFMA 1
#define TOPK_MFMA 1
#define SSM_MFMA 1
#define PROBE_MASK 0
#define P0_MASK 0
#define PROBE_GEMM 0
constexpr int BATCH = 4, SEQ = 2048, DM = 4096, T = BATCH * SEQ;
constexpr int NIN = 8192, AW = 2048, SW = 2048, NH = 16, HD = 128;
#ifndef NSPLIT_
#define NSPLIT_ 4096
#endif
constexpr int NSPLIT = NSPLIT_;
constexpr int MOBA_BLK = 256, MOBA_NB = 8;
constexpr int SG = 128, SC = 16, SP = 64;
constexpr int PH = 8, PK = 128, PQ = 256, PE = 16384, PTOP = 16, PSEL = PH * PTOP;
constexpr float RMS_EPS = 1e-6f;
constexpr float LOG2E = 1.4426950408889634f;
namespace pg8 {
#define PG8_LAS __attribute__((address_space(3)))
typedef unsigned short bf16_t;
typedef short bf16x8 __attribute__((ext_vector_type(8)));
typedef float f32x4 __attribute__((ext_vector_type(4)));
typedef unsigned u32x4 __attribute__((ext_vector_type(4)));
constexpr int BM = 256, BK = 64, HALF = 128, HTB = HALF * BK * 2  , STAGE_BYTES = 8 * HTB, NXCD = 8, WGM = 8;

__host__ __device__ __forceinline__ int lds_byte(int r, int c) { const int st = (r >> 4) * 2 + (c >> 5), rr = r & 15, cc = c & 31, ob = rr * 64 + cc * 2; return st * 1024 + (ob ^ (((ob >> 9) & 1) << 5)); }
__host__ __device__ __forceinline__ void stage_rc(int b, int& R, int& C) { const int st = b / 1024, sb = b % 1024, swz = sb ^ (((sb >> 9) & 1) << 5); R = (st >> 1) * 16 + swz / 64; C = (st & 1) * 32 + (swz % 64) / 2; }
__host__ __device__ __forceinline__ int perm32(int rho) { const int n = rho >> 4, i = rho & 15; return 8 * (i >> 2) + 4 * n + (i & 3); }

struct Unit { int pm, pn; };
struct Gemm { const bf16_t* A; const bf16_t* Bt; int M, N, K; };

struct StaticOrder {
    int nM, nN, nwg, G, c;
    __host__ __device__ void init(int M, int N, int G_, int c_) { nM = M / BM; nN = N / BM; nwg = nM * nN; G = G_; c = c_; }
    __host__ __device__ __forceinline__ bool next(int i, Unit& u) const {
        const long L = (long)i * G + c; if (L >= nwg) return false;
        int wgid = (int)L; { const int q = nwg / NXCD, r = nwg % NXCD, xcd = wgid % NXCD, off = wgid / NXCD; wgid = (xcd < r ? xcd * (q + 1) : r * (q + 1) + (xcd - r) * q) + off; }
        const int nig = WGM * nN, gid = wgid / nig, fm = gid * WGM, gsz = (nM - fm) < WGM ? (nM - fm) : WGM;
        u.pm = fm + ((wgid % nig) % gsz); u.pn = (wgid % nig) / gsz; return true;
    }
    __device__ __forceinline__ void a_ready(const Unit&) const {}
    __device__ __forceinline__ void done(const Unit&) const {}
};
struct OneOrder : StaticOrder { int only; __host__ __device__ bool next(int i, Unit& u) const { return i == 0 ? StaticOrder::next(only, u) : false; } };
__device__ __forceinline__ unsigned cvt_pk_bf16(float lo, float hi) { unsigned r; asm volatile("v_cvt_pk_bf16_f32 %0, %1, %2" : "=v"(r) : "v"(lo), "v"(hi)); return r; }
typedef float f32x2 __attribute__((ext_vector_type(2)));
__device__ __forceinline__ f32x2 gelu_pk(f32x2 v) {
    const f32x2 av = __builtin_elementwise_abs(v), d = av * 0.2316418882f + 1.0f;
    f32x2 t; t.x = __builtin_amdgcn_rcpf(d.x); t.y = __builtin_amdgcn_rcpf(d.y);
    f32x2 q = t * 0.5307027145f + (-0.7265760135f); q = q * t + 0.7107068705f; q = q * t + (-0.142248368f); q = q * t + 0.127414796f; q = q * t;
    const f32x2 s = (v * v) * (-0.72134752044f);
    f32x2 e; e.x = __builtin_amdgcn_exp2f(s.x); e.y = __builtin_amdgcn_exp2f(s.y);
    const f32x2 m = v * (q * e), r = v - m;
    f32x2 o; o.x = v.x < 0.f ? m.x : r.x; o.y = v.y < 0.f ? m.y : r.y; return o;
}
__device__ __forceinline__ float bf2f(unsigned short b) { return __uint_as_float(((unsigned)b) << 16); }
__device__ __forceinline__ float bflo(unsigned w) { return __uint_as_float(w << 16); }
__device__ __forceinline__ float bfhi(unsigned w) { return __uint_as_float(w & 0xffff0000u); }

__device__ __forceinline__ unsigned pk4_fp8(float a, float b, float c, float d) {
    int r = 0; r = __builtin_amdgcn_cvt_pk_fp8_f32(__builtin_amdgcn_fmed3f(a, -448.f, 448.f), __builtin_amdgcn_fmed3f(b, -448.f, 448.f), r, false);
    r = __builtin_amdgcn_cvt_pk_fp8_f32(__builtin_amdgcn_fmed3f(c, -448.f, 448.f), __builtin_amdgcn_fmed3f(d, -448.f, 448.f), r, true); return (unsigned)r; }
constexpr float FP8_SX1 = 8.0f, FP8_SWQ = 2048.0f;
constexpr float FP8_SH = 32.0f, FP8_SWI = 2048.0f;
constexpr float FP8_SYA = 64.0f, FP8_SYS = 32.0f, FP8_SWO = 2048.0f;
struct EpiInProj {
    static constexpr bool PERM = true, AFTER_DRAIN = false;
    bf16_t* qkv; bf16_t* ub; int pn0; float sc;
    __device__ __forceinline__ void operator()(const f32x4 (&acc)[2][2][4][2], const Unit& u, int wr, int wc, int fr, int fq) const {
        const int region = (u.pn + pn0) >> 3, pnr = (u.pn + pn0) & 7;
        const int row0 = u.pm * BM + wr * 64 + fr;
#pragma unroll
        for (int ai = 0; ai < 2; ++ai)
#pragma unroll
            for (int m = 0; m < 4; ++m) {
                const int row = row0 + ai * HALF + m * 16; const int b = row >> 11, s = row & 2047;
#pragma unroll
                for (int bj = 0; bj < 2; ++bj) {
                    const int col = pnr * 256 + bj * HALF + wc * 32 + 8 * fq;
                    bf16_t* p;
                    if (region < 3) { const int h = col >> 7, d = col & 127; p = qkv + (size_t)region * ((size_t)T * 2048) + ((size_t)((b * NH + h) * SEQ + s)) * HD + d; }
                    else p = ub + ((size_t)((b * 128 + (col >> 4)) * SEQ + s)) * 16 + (col & 15);
                    const f32x4 v0 = acc[ai][bj][m][0] * sc, v1 = acc[ai][bj][m][1] * sc;
                    u32x4 w; w.x = cvt_pk_bf16(v0[0], v0[1]); w.y = cvt_pk_bf16(v0[2], v0[3]); w.z = cvt_pk_bf16(v1[0], v1[1]); w.w = cvt_pk_bf16(v1[2], v1[3]);
                    *(u32x4*)p = w;
                }
            }
    }
};
struct EpiGlu {
    static constexpr bool PERM = true, AFTER_DRAIN = false;
    const bf16_t* yg; bf16_t* ycat; float* ssq;
    __device__ __forceinline__ void piece(const f32x4 a0, const f32x4 a1, const u32x4 yv, unsigned& wx, unsigned& wy, float& ss) const {
        float y[8] = {bflo(yv.x), bfhi(yv.x), bflo(yv.y), bfhi(yv.y), bflo(yv.z), bfhi(yv.z), bflo(yv.w), bfhi(yv.w)};
        float a[8] = {a0[0], a0[1], a0[2], a0[3], a1[0], a1[1], a1[2], a1[3]};
        float o[8];
#pragma unroll
        for (int j = 0; j < 8; ++j) { const float sg = __builtin_amdgcn_rcpf(1.0f + __builtin_amdgcn_exp2f(-a[j] * LOG2E)); o[j] = y[j] * sg; ss += o[j] * o[j]; }
        wx = pk4_fp8(o[0] * FP8_SYS, o[1] * FP8_SYS, o[2] * FP8_SYS, o[3] * FP8_SYS); wy = pk4_fp8(o[4] * FP8_SYS, o[5] * FP8_SYS, o[6] * FP8_SYS, o[7] * FP8_SYS);
    }
    __device__ __forceinline__ void operator()(const f32x4 (&acc)[2][2][4][2], const Unit& u, int wr, int wc, int fr, int fq) const {
        const int row0 = u.pm * BM + wr * 64 + fr;
#pragma unroll
        for (int ai = 0; ai < 2; ++ai)
#pragma unroll
            for (int mp = 0; mp < 4; mp += 2) {
                const int rowA = row0 + ai * HALF + mp * 16, rowB = rowA + 16; float ssA = 0.f, ssB = 0.f;
#pragma unroll
                for (int bj = 0; bj < 2; ++bj) {
                    const int col = u.pn * BM + bj * HALF + wc * 32 + 8 * fq;
                    const u32x4 yA = *(const u32x4*)(yg + (size_t)rowA * SW + col), yB = *(const u32x4*)(yg + (size_t)rowB * SW + col);
                    unsigned ax, ay, bx, by;
                    piece(acc[ai][bj][mp][0], acc[ai][bj][mp][1], yA, ax, ay, ssA); piece(acc[ai][bj][mp + 1][0], acc[ai][bj][mp + 1][1], yB, bx, by, ssB);
                    const auto sx = __builtin_amdgcn_permlane16_swap(ax, bx, false, false); const auto sy = __builtin_amdgcn_permlane16_swap(ay, by, false, false);
                    const u32x4 w = {sx[0], sy[0], sx[1], sy[1]};
                    const int rowS = (fq & 1) ? rowB : rowA, colS = col - 8 * (fq & 1);
                    *(u32x4*)((unsigned char*)ycat + (size_t)rowS * DM + AW + colS) = w;
                }
                ssA += __shfl_xor(ssA, 16); ssA += __shfl_xor(ssA, 32); ssB += __shfl_xor(ssB, 16); ssB += __shfl_xor(ssB, 32);
                if (fq == 0) { atomicAdd(ssq + rowA, ssA); atomicAdd(ssq + rowB, ssB); }
            }
    }
};
struct EpiOutProj {
    static constexpr bool PERM = true, AFTER_DRAIN = false;
    const float* x; bf16_t* x1bf; float* ssq; const float* ssqa; const float* ssqs; unsigned char* x1f8;
    __device__ __forceinline__ void mid(f32x4 (&acc)[2][2][4][2], const Unit& u, int wr, int fr) const {
        int row0 = u.pm * BM + wr * 64 + fr; asm volatile("" : "+v"(row0));
#pragma unroll
        for (int ai = 0; ai < 2; ++ai)
#pragma unroll
            for (int m = 0; m < 4; ++m) { const int row = row0 + ai * HALF + m * 16;
                const float ra = 1.0f / sqrtf(ssqa[row] * (1.0f / AW) + RMS_EPS), rsi = sqrtf(ssqs[row] * (1.0f / SW) + RMS_EPS); const float ratio = ra * rsi * (FP8_SYS / FP8_SYA);
#pragma unroll
                for (int bj = 0; bj < 2; ++bj)
#pragma unroll
                    for (int n = 0; n < 2; ++n) acc[ai][bj][m][n] = acc[ai][bj][m][n] * ratio; }
    }
    __device__ __forceinline__ void operator()(const f32x4 (&acc)[2][2][4][2], const Unit& u, int wr, int wc, int fr, int fq) const {
        typedef unsigned u32x2v __attribute__((ext_vector_type(2)));
        const int row0 = u.pm * BM + wr * 64 + fr, col0 = u.pn * BM + wc * 32 + 8 * fq;
#pragma unroll
        for (int ai = 0; ai < 2; ++ai)
#pragma unroll
            for (int mp = 0; mp < 4; mp += 2) {
                unsigned w8x[2][2], w8y[2][2];
#pragma unroll
                for (int mm = 0; mm < 2; ++mm) { const int m = mp + mm;
                    const int row = row0 + ai * HALF + m * 16; float ss = 0.f; const size_t off = (size_t)row * DM + col0;
                    const float rs = (1.0f / (FP8_SYS * FP8_SWO)) / sqrtf(ssqs[row] * (1.0f / SW) + RMS_EPS);
#pragma unroll
                    for (int bj = 0; bj < 2; ++bj) {
                        const f32x4 xa = *(const f32x4*)(x + off + bj * HALF), xb = *(const f32x4*)(x + off + bj * HALF + 4);
                        const f32x4 oa = xa + acc[ai][bj][m][0] * rs, ob = xb + acc[ai][bj][m][1] * rs;
                        u32x4 w; w.x = cvt_pk_bf16(oa[0], oa[1]); w.y = cvt_pk_bf16(oa[2], oa[3]); w.z = cvt_pk_bf16(ob[0], ob[1]); w.w = cvt_pk_bf16(ob[2], ob[3]);
                        *(u32x4*)(x1bf + off + bj * HALF) = w;
                        w8x[mm][bj] = pk4_fp8(oa[0] * FP8_SX1, oa[1] * FP8_SX1, oa[2] * FP8_SX1, oa[3] * FP8_SX1); w8y[mm][bj] = pk4_fp8(ob[0] * FP8_SX1, ob[1] * FP8_SX1, ob[2] * FP8_SX1, ob[3] * FP8_SX1);
                        ss += ((oa[0] * oa[0] + oa[1] * oa[1]) + (oa[2] * oa[2] + oa[3] * oa[3])) + ((ob[0] * ob[0] + ob[1] * ob[1]) + (ob[2] * ob[2] + ob[3] * ob[3]));
                    }
                    ss += __shfl_xor(ss, 16); ss += __shfl_xor(ss, 32);
                    if (fq == 0 && ssq) atomicAdd(ssq + row, ss);
                }
#pragma unroll
                for (int bj = 0; bj < 2; ++bj) {
                    const auto sx = __builtin_amdgcn_permlane16_swap(w8x[0][bj], w8x[1][bj], false, false); const auto sy = __builtin_amdgcn_permlane16_swap(w8y[0][bj], w8y[1][bj], false, false);
                    const u32x4 w = {sx[0], sy[0], sx[1], sy[1]};
                    const int rowS = row0 + ai * HALF + (mp + (fq & 1)) * 16;
                    *(u32x4*)(x1f8 + (size_t)rowS * DM + col0 - 8 * (fq & 1) + bj * HALF) = w;
                }
            }
    }
};
struct EpiPeerQ {
    static constexpr bool PERM = true, AFTER_DRAIN = false;
    const float* ssq; bf16_t* qp;
    __device__ __forceinline__ void operator()(const f32x4 (&acc)[2][2][4][2], const Unit& u, int wr, int wc, int fr, int fq) const {
        asm volatile("" : "+v"(fr), "+v"(fq));
        const int row0 = u.pm * BM + wr * 64 + fr;
#pragma unroll
        for (int ai = 0; ai < 2; ++ai)
#pragma unroll
            for (int m = 0; m < 4; ++m) {
                const int row = row0 + ai * HALF + m * 16;
                const float r = (1.0f / (FP8_SX1 * FP8_SWQ)) / sqrtf(ssq[row] * (1.0f / DM) + RMS_EPS);
#pragma unroll
                for (int bj = 0; bj < 2; ++bj) {
                    const int col = u.pn * BM + bj * HALF + wc * 32 + 8 * fq;
                    const f32x4 v0 = acc[ai][bj][m][0] * r, v1 = acc[ai][bj][m][1] * r;
                    u32x4 w; w.x = cvt_pk_bf16(v0[0], v0[1]); w.y = cvt_pk_bf16(v0[2], v0[3]); w.z = cvt_pk_bf16(v1[0], v1[1]); w.w = cvt_pk_bf16(v1[2], v1[3]);
                    *(u32x4*)(qp + (size_t)row * 2048 + col) = w;
                }
            }
    }
};
template <class Epi, class Sched, bool ALIGN_EPI = false, bool SP2 = false, bool MIDK = false, bool FP8 = false>
__device__ __forceinline__ void gemm_phase(PG8_LAS unsigned char* lds, const Gemm g, const Sched& S, const Epi& E) {
    const int tid = threadIdx.x, wid = __builtin_amdgcn_readfirstlane(tid >> 6), lane = tid & 63, wr = wid >> 2, wc = wid & 3, fr = lane & 15, fq = lane >> 4;
    const int K = FP8 ? g.K / 2 : g.K, nt = K / BK;
    unsigned voffA[2], voffB[2];
#pragma unroll
    for (int i = 0; i < 2; ++i) { int R, C; stage_rc(tid * 16 + i * 8192, R, C); const int Rb = Epi::PERM ? ((R & ~31) + perm32(R & 31)) : R;
        voffA[i] = (unsigned)(R * K + C) * 2u; voffB[i] = (unsigned)(Rb * K + C) * 2u; }
    const unsigned kstep = (unsigned)(BK * 2);
    const unsigned hstep = (unsigned)HALF * K * 2;
    const unsigned tstep = 2 * hstep;
    const unsigned ldsw = (unsigned)wid * 1024u;
    const int aoff = lds_byte(wr * 64 + fr, fq * 8), boff = lds_byte(wc * 32 + fr, fq * 8);
#define PG8_SA(b, h) (((b) * 2 + (h)) * HTB)
#define PG8_SB(b, h) ((4 + (b) * 2 + (h)) * HTB)
    const __amdgpu_buffer_rsrc_t rsA = __builtin_amdgcn_make_buffer_rsrc((void*)g.A, (short)0, (int)0x7ffff000, 0x00020000), rsB = __builtin_amdgcn_make_buffer_rsrc((void*)g.Bt, (short)0, (int)0x7ffff000, 0x00020000);
#define PG8_STAGE(bufoff, gbase, voff) do { _Pragma("unroll") for (int _i = 0; _i < 2; ++_i) \
        __builtin_amdgcn_raw_ptr_buffer_load_lds(PG8_RS_##voff, (PG8_LAS unsigned*)(lds + (bufoff) + ldsw + _i * 8192), 16, (int)(voff)[_i], (int)(gbase), 0, 0); } while (0)
#define PG8_RS_voffA rsA
#define PG8_RS_voffB rsB
#define PG8_LDA(dst, b, h) do { _Pragma("unroll") for (int m = 0; m < 4; ++m) _Pragma("unroll") for (int k = 0; k < 2; ++k) dst[m][k] = *(const PG8_LAS bf16x8*)(lds + PG8_SA(b, h) + aoff + m * 2048 + k * 1024); } while (0)
#define PG8_LDB(dst, b, h) do { _Pragma("unroll") for (int n = 0; n < 2; ++n) _Pragma("unroll") for (int k = 0; k < 2; ++k) dst[n][k] = *(const PG8_LAS bf16x8*)(lds + PG8_SB(b, h) + boff + n * 2048 + k * 1024); } while (0)
#define PG8_MMA(ai, bj, At, Bt) do { __builtin_amdgcn_s_setprio(1); _Pragma("unroll") for (int m = 0; m < 4; ++m) _Pragma("unroll") for (int n = 0; n < 2; ++n) { \
        if constexpr (FP8) { typedef int pg8_v4i __attribute__((ext_vector_type(4))); typedef int pg8_v8i __attribute__((ext_vector_type(8))); \
            const pg8_v8i bv_ = __builtin_shufflevector(__builtin_bit_cast(pg8_v4i, Bt[n][0]), __builtin_bit_cast(pg8_v4i, Bt[n][1]), 0, 1, 2, 3, 4, 5, 6, 7); \
            const pg8_v8i av_ = __builtin_shufflevector(__builtin_bit_cast(pg8_v4i, At[m][0]), __builtin_bit_cast(pg8_v4i, At[m][1]), 0, 1, 2, 3, 4, 5, 6, 7); \
              \
            asm volatile("v_mfma_scale_f32_16x16x128_f8f6f4 %0, %1, %2, %0, %3, %3 op_sel_hi:[0,0,0]" : "+v"(acc[ai][bj][m][n]) : "v"(bv_), "v"(av_), "v"(mxscale)); } \
        else { _Pragma("unroll") for (int k = 0; k < 2; ++k) acc[ai][bj][m][n] = __builtin_amdgcn_mfma_f32_16x16x32_bf16(Bt[n][k], At[m][k], acc[ai][bj][m][n], 0, 0, 0); } } \
        __builtin_amdgcn_s_setprio(0); } while (0)
#define PG8_WAIT_V(n) asm volatile("s_waitcnt vmcnt(" #n ")" ::: "memory")
#define PG8_WAIT_L(n) asm volatile("s_waitcnt lgkmcnt(" #n ")" ::: "memory")
#define PG8_BAR __builtin_amdgcn_s_barrier()
#define PG8_SCHED __builtin_amdgcn_sched_barrier(0)
    Unit cur, nxt; int ui = 0;
    if (!S.next(0, cur)) return;
    int mxscale = 0x7f7f7f7f; asm volatile("" : "+v"(mxscale));
    f32x4 acc[2][2][4][2];
#pragma unroll
    for (int a = 0; a < 2; ++a)
#pragma unroll
        for (int b = 0; b < 2; ++b)
#pragma unroll
            for (int m = 0; m < 4; ++m)
#pragma unroll
                for (int n = 0; n < 2; ++n) acc[a][b][m][n] = (f32x4){0.f, 0.f, 0.f, 0.f};
    bf16x8 At[4][2], B0[2][2], B1[2][2];
    unsigned cA = (unsigned)cur.pm * tstep, cB = (unsigned)cur.pn * tstep;
    S.a_ready(cur);
    if constexpr (SP2) {
        PG8_STAGE(PG8_SB(0, 0), cB, voffB); PG8_STAGE(PG8_SB(0, 1), cB + hstep, voffB); PG8_STAGE(PG8_SA(0, 0), cA, voffA); PG8_STAGE(PG8_SA(0, 1), cA + hstep, voffA);
        if (wr == 1) PG8_BAR;
        PG8_WAIT_V(2); PG8_BAR;
        PG8_STAGE(PG8_SB(1, 0), cB + kstep, voffB); PG8_STAGE(PG8_SA(1, 0), cA + kstep, voffA); PG8_STAGE(PG8_SB(1, 1), cB + hstep + kstep, voffB);
        PG8_WAIT_V(6); PG8_BAR;
    } else {
        PG8_STAGE(PG8_SB(0, 0), cB, voffB); PG8_STAGE(PG8_SA(0, 0), cA, voffA); PG8_STAGE(PG8_SB(0, 1), cB + hstep, voffB); PG8_STAGE(PG8_SA(0, 1), cA + hstep, voffA);
        if (wr == 1) PG8_BAR;
        PG8_WAIT_V(4); PG8_BAR;
        PG8_STAGE(PG8_SB(1, 0), cB + kstep, voffB); PG8_STAGE(PG8_SA(1, 0), cA + kstep, voffA); PG8_STAGE(PG8_SB(1, 1), cB + hstep + kstep, voffB);
        PG8_WAIT_V(6); PG8_BAR;
    }
    for (;;) {
        const bool has_next = S.next(ui + 1, nxt);
        const unsigned nA = has_next ? (unsigned)nxt.pm * tstep : cA, nB = has_next ? (unsigned)nxt.pn * tstep : cB;
        for (int t = 0; t < nt; t += 2) {
            if constexpr (MIDK) { if (t == (nt >> 1)) { if constexpr (FP8) asm volatile("s_nop 15\n\ts_nop 15" ::: "memory"); E.mid(acc, cur, wr, fr); } }
            const bool last = (t == nt - 2);
            const unsigned a1 = cA + (unsigned)(t + 1) * kstep;
            const unsigned a2 = last ? nA : cA + (unsigned)(t + 2) * kstep, b2 = last ? nB : cB + (unsigned)(t + 2) * kstep;
            const unsigned a3 = a2 + kstep, b3 = b2 + kstep;
            if (last && has_next) S.a_ready(nxt);
            if constexpr (SP2) {
            PG8_LDB(B0, 0, 0); PG8_LDB(B1, 0, 1); PG8_SCHED; PG8_LDA(At, 0, 0); PG8_STAGE(PG8_SA(1, 1), a1 + hstep, voffA);
            PG8_WAIT_V(8); PG8_WAIT_L(0); PG8_BAR; PG8_MMA(0, 0, At, B0); PG8_MMA(0, 1, At, B1); PG8_BAR; PG8_SCHED;
            PG8_LDA(At, 0, 1); PG8_STAGE(PG8_SB(0, 0), b2, voffB); PG8_STAGE(PG8_SB(0, 1), b2 + hstep, voffB); PG8_STAGE(PG8_SA(0, 0), a2, voffA);
            PG8_WAIT_V(8); PG8_WAIT_L(0); PG8_BAR; PG8_MMA(1, 0, At, B0); PG8_MMA(1, 1, At, B1); PG8_BAR; PG8_SCHED;
            PG8_LDB(B0, 1, 0); PG8_LDB(B1, 1, 1); PG8_SCHED; PG8_LDA(At, 1, 0); PG8_STAGE(PG8_SA(0, 1), a2 + hstep, voffA);
            PG8_WAIT_V(8); PG8_WAIT_L(0); PG8_BAR; PG8_MMA(0, 0, At, B0); PG8_MMA(0, 1, At, B1); PG8_BAR; PG8_SCHED;
            PG8_LDA(At, 1, 1); PG8_STAGE(PG8_SB(1, 0), b3, voffB); PG8_STAGE(PG8_SB(1, 1), b3 + hstep, voffB); PG8_STAGE(PG8_SA(1, 0), a3, voffA);
            PG8_WAIT_V(8); PG8_WAIT_L(0); PG8_BAR; PG8_MMA(1, 0, At, B0); PG8_MMA(1, 1, At, B1); PG8_BAR; PG8_SCHED;
            } else {
            PG8_LDB(B0, 0, 0); PG8_SCHED; PG8_LDA(At, 0, 0); PG8_STAGE(PG8_SA(1, 1), a1 + hstep, voffA);
            PG8_WAIT_L(8); PG8_BAR; PG8_WAIT_L(0); PG8_MMA(0, 0, At, B0); PG8_BAR; PG8_SCHED;
            PG8_LDB(B1, 0, 1); PG8_STAGE(PG8_SB(0, 0), b2, voffB);
            PG8_BAR; PG8_WAIT_L(0); PG8_MMA(0, 1, At, B1); PG8_BAR;
            PG8_LDA(At, 0, 1); PG8_STAGE(PG8_SA(0, 0), a2, voffA);
            PG8_BAR; PG8_WAIT_L(0); PG8_MMA(1, 0, At, B0); PG8_BAR; PG8_SCHED;
            PG8_STAGE(PG8_SB(0, 1), b2 + hstep, voffB);
            PG8_WAIT_V(6); PG8_BAR; PG8_MMA(1, 1, At, B1); PG8_BAR;
            PG8_LDB(B0, 1, 0); PG8_SCHED; PG8_LDA(At, 1, 0); PG8_STAGE(PG8_SA(0, 1), a2 + hstep, voffA);
            PG8_WAIT_L(8); PG8_BAR; PG8_WAIT_L(0); PG8_MMA(0, 0, At, B0); PG8_BAR; PG8_SCHED;
            PG8_LDB(B1, 1, 1); PG8_STAGE(PG8_SB(1, 0), b3, voffB);
            PG8_BAR; PG8_WAIT_L(0); PG8_MMA(0, 1, At, B1); PG8_BAR;
            PG8_LDA(At, 1, 1); PG8_STAGE(PG8_SA(1, 0), a3, voffA);
            PG8_BAR; PG8_WAIT_L(0); PG8_MMA(1, 0, At, B0); PG8_BAR; PG8_SCHED;
            PG8_STAGE(PG8_SB(1, 1), b3 + hstep, voffB);
            PG8_WAIT_V(6); PG8_BAR; PG8_MMA(1, 1, At, B1); PG8_BAR;
            }
        }
        if constexpr (FP8) asm volatile("s_nop 15\n\ts_nop 15" ::: "memory");
        if constexpr (ALIGN_EPI) { if (wr == 0) PG8_BAR; }
        if constexpr (!Epi::AFTER_DRAIN) { E(acc, cur, wr, wc, fr, fq); S.done(cur); }
        if (!has_next) break;
#pragma unroll
        for (int a = 0; a < 2; ++a)
#pragma unroll
            for (int b = 0; b < 2; ++b)
#pragma unroll
                for (int m = 0; m < 4; ++m)
#pragma unroll
                    for (int n = 0; n < 2; ++n) acc[a][b][m][n] = (f32x4){0.f, 0.f, 0.f, 0.f};
        cur = nxt; cA = nA; cB = nB; ++ui;
        if constexpr (ALIGN_EPI) { if (wr == 1) PG8_BAR; }
    }
    PG8_WAIT_V(0);
    if constexpr (!ALIGN_EPI) { if (wr == 0) PG8_BAR; }
    PG8_BAR;
    if constexpr (Epi::AFTER_DRAIN) { E.fused(acc, cur, wr, wc, fr, fq, lds, wid, lane); S.done(cur); }
#undef PG8_SA
#undef PG8_SB
#undef PG8_STAGE
#undef PG8_RS_voffA
#undef PG8_RS_voffB
#undef PG8_LDA
#undef PG8_LDB
#undef PG8_MMA
#undef PG8_WAIT_V
#undef PG8_WAIT_L
#undef PG8_BAR
#undef PG8_SCHED
}
}
constexpr int NWAVES = 8;
constexpr size_t MiB = 1u << 20;
constexpr size_t WS_CTL = 0, CTL_ZERO_BYTES = 1 * MiB;
constexpr size_t WS_WIN = 2 * MiB;
constexpr size_t WS_WGLU = 66 * MiB;
constexpr size_t WS_WOUT = 74 * MiB;
constexpr size_t WS_WQ = 106 * MiB;
constexpr size_t WS_KEYS = 122 * MiB;
constexpr size_t WS_KMEAN = 123 * MiB;
constexpr size_t WS_BLUT = 123 * MiB + 512 * 1024;
constexpr size_t WS_SU = 123 * MiB + 768 * 1024;
constexpr size_t WS_SV = 123 * MiB + 896 * 1024;
constexpr size_t WS_SKERN = 124 * MiB;
constexpr size_t WS_SW = 130 * MiB;
constexpr size_t WS_SVM = 162 * MiB;
constexpr size_t WS_H = 194 * MiB;
constexpr size_t WS_QKV = 258 * MiB;
constexpr size_t WS_U = 354 * MiB;
constexpr size_t WS_YG = 386 * MiB;
constexpr size_t WS_YCAT = 418 * MiB;
constexpr size_t WS_X1 = 482 * MiB;
constexpr size_t WS_X1BF = 610 * MiB;
constexpr size_t WS_QP = 674 * MiB;
constexpr size_t WS_EXP = 706 * MiB;
constexpr size_t WS_GATE = 710 * MiB;
constexpr size_t WS_U8 = 714 * MiB;
constexpr size_t WS_V8 = 778 * MiB;
constexpr size_t WS_END = 842 * MiB;
constexpr size_t WS_XH = WS_H, WS_XL = WS_H + 16 * MiB, WS_XS = WS_H + 32 * MiB;
constexpr size_t WS_X1F8 = WS_YG;
constexpr size_t WS_X2B = WS_YCAT;
constexpr size_t WS_CB = WS_X1, WS_TS = WS_X1 + 4 * MiB;
constexpr size_t WS_WIN8 = WS_WIN + 48 * MiB;
constexpr size_t WS_H8 = WS_X1 + 16 * MiB;
constexpr size_t WS_PART = WS_QKV;
constexpr int CW_BAR = 4096;
constexpr int CW_SSQA = 65536, CW_SSQS = CW_SSQA + T, CW_SSQ1 = CW_SSQS + T;
constexpr int CW_SSQAT = CW_SSQ1 + T;
static_assert((CW_SSQAT + T) * 4 <= (int)CTL_ZERO_BYTES, "ctl");
constexpr int RING_OFF = 0, RING_BYTES = 131072;
constexpr int LDSCTL_OFF = RING_BYTES, MISC_OFF = LDSCTL_OFF + 320;
constexpr int LDS_BYTES = 147456;

#define GAS __attribute__((address_space(1)))
#define LAS __attribute__((address_space(3)))
typedef unsigned short bf16;
typedef unsigned v4u __attribute__((ext_vector_type(4)));
typedef unsigned v2u __attribute__((ext_vector_type(2)));
typedef float f32x4 __attribute__((ext_vector_type(4)));
typedef float f32x2 __attribute__((ext_vector_type(2)));
typedef GAS unsigned gu32;
#define LDS_WAIT() asm volatile("s_waitcnt lgkmcnt(0)" ::: "memory")
#define VM_WAIT() asm volatile("s_waitcnt vmcnt(0)" ::: "memory")
__device__ __forceinline__ unsigned pk2(float lo, float hi) { unsigned r; asm("v_cvt_pk_bf16_f32 %0, %1, %2" : "=v"(r) : "v"(lo), "v"(hi)); return r; }
__device__ __forceinline__ unsigned f2bf(float f) { return pk2(f, 0.f) & 0xffffu; }
__device__ __forceinline__ float bf2f(unsigned short b) { return __uint_as_float(((unsigned)b) << 16); }
__device__ __forceinline__ float bflo(unsigned w) { return __uint_as_float(w << 16); }
__device__ __forceinline__ float bfhi(unsigned w) { return __uint_as_float(w & 0xffff0000u); }
__device__ __forceinline__ float wave_sum(float v) {
#pragma unroll
    for (int o = 1; o < 64; o <<= 1) v += __shfl_xor(v, o);
    return v;
}
__device__ __forceinline__ float wave_max(float v) {
#pragma unroll
    for (int o = 1; o < 64; o <<= 1) v = fmaxf(v, __shfl_xor(v, o));
    return v;
}
__device__ __forceinline__ float gelu_erf(float v) { return 0.5f * v * (1.0f + erff(v * 0.70710678118654752f)); }
#define XB_TMO      128
#define XB_XCNT(j)  (256  + 64 * (j))
#define XB_XSUB(j)  (1280 + 64 * (j))
#define XB_XGEN(j)  (2304 + 64 * (j))
#define XB_TOP      3328
#define XB_TOPGEN   3392
#define XCD_BAR_WORDS 3456
#define XB_SPIN_CAP (1u << 18)

__device__ __forceinline__ unsigned xb_ld(unsigned* p)              { return __hip_atomic_load(p, __ATOMIC_RELAXED, __HIP_MEMORY_SCOPE_AGENT); }
__device__ __forceinline__ unsigned xb_add(unsigned* p, unsigned v) { return __hip_atomic_fetch_add(p, v, __ATOMIC_RELAXED, __HIP_MEMORY_SCOPE_AGENT); }
__device__ __forceinline__ unsigned xb_xcc_id() { return (unsigned)__builtin_amdgcn_s_getreg((3 << 11) | 20) & 0xFu; }
#define XB_SPIN(cond, bar) do { unsigned _sp = 0; while (cond) { __builtin_amdgcn_s_sleep(1); \
    if ((++_sp & 255u) == 0u) { if (xb_ld(&(bar)[XB_TMO])) break; if (_sp > XB_SPIN_CAP) { atomicAdd(&(bar)[XB_TMO], 1u); break; } } } } while (0)

struct XcdBarrier {
    unsigned* bar; unsigned x;
    volatile LAS unsigned* st;
};

__device__ __forceinline__ XcdBarrier xcd_barrier_post(unsigned* bar, volatile LAS unsigned* st) {
    XcdBarrier b; b.bar = bar; b.x = xb_xcc_id(); b.st = st;
    if (threadIdx.x == 0) (void)xb_add(&bar[XB_XCNT(b.x)], 1u);
    return b;
}
__device__ __forceinline__ void xcd_barrier_complete(unsigned* bar, unsigned x, unsigned& nloc, unsigned& nx) {
    const unsigned G = gridDim.x * gridDim.y * gridDim.z;
    unsigned sum, cnt, mine, sp = 0u;
    for (;;) {
        sum = 0u; cnt = 0u; mine = 0u;
#pragma unroll
        for (unsigned j = 0; j < 16; ++j) { const unsigned c = xb_ld(&bar[XB_XCNT(j)]); sum += c; cnt += (c > 0u) ? 1u : 0u; mine = (j == x) ? c : mine; }
        if (sum == G) break;
        __builtin_amdgcn_s_sleep(1);
        if ((++sp & 255u) == 0u) { if (xb_ld(&bar[XB_TMO])) break; if (sp > XB_SPIN_CAP) { atomicAdd(&bar[XB_TMO], 1u); break; } }
    }
    nloc = mine > 0u ? mine : 1u; nx = cnt > 0u ? cnt : 1u;
}

__device__ __forceinline__ void xcd_barrier(const XcdBarrier& b) {
    asm volatile("s_waitcnt vmcnt(0)" ::: "memory");
    __syncthreads();
    if (threadIdx.x == 0) {
        unsigned* bar = b.bar;
        __builtin_amdgcn_s_waitcnt(0);
        unsigned nloc = b.st[0], nx = b.st[1];
        if (nloc == 0u) { xcd_barrier_complete(bar, b.x, nloc, nx); b.st[0] = nloc; b.st[1] = nx; }
        const unsigned old = xb_add(&bar[XB_XSUB(b.x)], 1u);
        const unsigned gen = old / nloc;
        if (old + 1u == (gen + 1u) * nloc) {
            __builtin_amdgcn_fence(__ATOMIC_RELEASE, "agent");
            asm volatile("s_waitcnt vmcnt(0)" ::: "memory");
            const unsigned og = xb_add(&bar[XB_TOP], 1u);
            const unsigned tg = og / nx;
            if (og + 1u == (tg + 1u) * nx) xb_add(&bar[XB_TOPGEN], 1u);
            else XB_SPIN(xb_ld(&bar[XB_TOPGEN]) == tg, bar);
            __builtin_amdgcn_fence(__ATOMIC_ACQUIRE, "agent");
            xb_add(&bar[XB_XGEN(b.x)], 1u);
            asm volatile("s_waitcnt vmcnt(0)" ::: "memory");
        } else {
            XB_SPIN(xb_ld(&bar[XB_XGEN(b.x)]) == gen, bar);
            __builtin_amdgcn_fence(__ATOMIC_ACQUIRE, "agent");
            asm volatile("s_waitcnt vmcnt(0)" ::: "memory");
        }
    }
    __syncthreads();
}
namespace att {
#define ALAS __attribute__((address_space(3)))
typedef unsigned short bf16;
typedef short bf16x8 __attribute__((ext_vector_type(8)));
typedef short s16x4 __attribute__((ext_vector_type(4)));
typedef float f32x16 __attribute__((ext_vector_type(16)));
typedef float f32x4 __attribute__((ext_vector_type(4)));
typedef unsigned u32x4 __attribute__((ext_vector_type(4)));
template <class A, class Bt> struct same_t { static constexpr bool v = false; };
template <class A> struct same_t<A, A> { static constexpr bool v = true; };
constexpr int D = 128;
constexpr float THR = 8.f;
constexpr float SCALE = 0.08838834764831845f;
constexpr int NW = 8, QBLK = 32, KVBLK = 64, QB = NW * QBLK;
constexpr int SHM_V = KVBLK * D * 2, SHM_K = KVBLK * D * 2;
#define KSWZ(row, colB) ((row) * 256 + ((colB) ^ (((row) & 7) << 4)))
#define SBAR() __builtin_amdgcn_sched_barrier(0)
__device__ __forceinline__ int v_st(int k, int c) { const int kk = (k & ~0xC) | ((k & 4) << 1) | ((k & 8) >> 1); return ((kk >> 3) * 4 + (c >> 5)) * 512 + ((kk & 7) * 32 + (c & 31)) * 2; }
__device__ __forceinline__ int v_rd_base(int lane) { return ((lane & 3) << 3) | (((lane >> 2) & 3) << 6) | (((lane >> 4) & 1) << 5) | (((lane >> 5) & 1) << 8); }
constexpr int v_rd_off(int d0, int ks, int half) { return d0 * 512 + ks * 4096 + half * 2048; }
__device__ __forceinline__ int crow(int r, int hi) { return (r & 3) + 8 * (r >> 2) + 4 * hi; }
__device__ __forceinline__ unsigned cvtpk(float lo, float hi) {
    unsigned r; asm volatile("v_cvt_pk_bf16_f32 %0, %1, %2" : "=v"(r) : "v"(lo), "v"(hi)); return r;
}
__device__ __forceinline__ bf16x8 pack8(f32x4 a, f32x4 b) {
    u32x4 w = {cvtpk(a[0], a[1]), cvtpk(a[2], a[3]), cvtpk(b[0], b[1]), cvtpk(b[2], b[3])};
    return *reinterpret_cast<bf16x8*>(&w);
}
template <class T> __device__ __forceinline__ bf16x8 load8(const T* p) {
    if constexpr (same_t<T, float>::v) { return pack8(*(const f32x4*)p, *(const f32x4*)(p + 4)); }
    else { return *reinterpret_cast<const bf16x8*>(p); }
}
__device__ __forceinline__ void mask_tile(f32x16& p0, f32x16& p1, int dq, unsigned W) {
    const float NEG = -__builtin_inff();
#pragma unroll
    for (int r = 0; r < 16; ++r) {
        const int c = (r & 3) + 8 * (r >> 2);
        if ((unsigned)(dq - c) >= W) p0[r] = NEG;
        if ((unsigned)(dq - c - 32) >= W) p1[r] = NEG;
    }
}
__device__ __forceinline__ void partialSM(f32x16& p0, f32x16& p1, float& m_reg, float& mn, float& alpha) {
    float pmax = p0[0]; for (int r = 1; r < 16; ++r) pmax = fmaxf(pmax, p0[r]); for (int r = 0; r < 16; ++r) pmax = fmaxf(pmax, p1[r]);
    { auto rr = __builtin_amdgcn_permlane32_swap(__float_as_uint(pmax), __float_as_uint(pmax), false, false);
      pmax = fmaxf(__uint_as_float(rr[0]), __uint_as_float(rr[1])); }
    constexpr float C2 = 1.4426950408889634f * SCALE;
    if (__builtin_expect(__all((pmax - m_reg) * SCALE <= THR), 1)) { mn = m_reg; alpha = 1.f; }
    else { mn = fmaxf(m_reg, pmax); alpha = __builtin_amdgcn_exp2f((m_reg - mn) * C2); m_reg = mn; }
    const float mnL = -mn * C2;
    for (int r = 0; r < 16; ++r) p0[r] = fmaf(p0[r], C2, mnL); for (int r = 0; r < 16; ++r) p1[r] = fmaf(p1[r], C2, mnL);
    for (int r = 0; r < 16; ++r) p0[r] = __builtin_amdgcn_exp2f(p0[r]);
}
__device__ __forceinline__ void finishSM(f32x16& p0, f32x16& p1, float alpha, float& l_reg, bf16x8& pa0, bf16x8& pa1, bf16x8& pa2, bf16x8& pa3) {
    for (int r = 0; r < 16; ++r) p1[r] = __builtin_amdgcn_exp2f(p1[r]);
    float ps = 0; for (int r = 0; r < 16; ++r) ps += p0[r]; for (int r = 0; r < 16; ++r) ps += p1[r];
    { auto rr = __builtin_amdgcn_permlane32_swap(__float_as_uint(ps), __float_as_uint(ps), false, false);
      ps = __uint_as_float(rr[0]) + __uint_as_float(rr[1]); }
    l_reg = l_reg * alpha + ps;
#define PK4(P, B_, OUT) do { unsigned a0 = cvtpk(P[B_+0], P[B_+1]), a1 = cvtpk(P[B_+2], P[B_+3]);                          \
        unsigned b0 = cvtpk(P[B_+4], P[B_+5]), b1 = cvtpk(P[B_+6], P[B_+7]);                                             \
        auto r0 = __builtin_amdgcn_permlane32_swap(a0, b0, false, false); auto r1 = __builtin_amdgcn_permlane32_swap(a1, b1, false, false); \
        u32x4 w = {r0[0], r1[0], r0[1], r1[1]}; OUT = *reinterpret_cast<bf16x8*>(&w); } while (0)
    PK4(p0, 0, pa0); PK4(p0, 8, pa1); PK4(p1, 0, pa2); PK4(p1, 8, pa3);
#undef PK4
}
template <int KB, bool SK>
__device__ __forceinline__ void qkt(f32x16& p0, f32x16& p1, const char* K_lds, int r32, int hi, const bf16x8* qr, bool act) {
    if (SK && !act) { const float NEG = -__builtin_inff();
#pragma unroll
        for (int r = 0; r < 16; ++r) { p0[r] = NEG; p1[r] = NEG; } return; }
    p0 = f32x16{}; p1 = f32x16{};
    const char* kb[4];
#pragma unroll
    for (int dd = 0; dd < 4; ++dd) kb[dd] = K_lds + KB * SHM_K + KSWZ(r32, (dd * 16 + hi * 8) * 2);
#pragma unroll
    for (int d0 = 0; d0 < 8; ++d0) { const char* a = kb[d0 & 3] + (d0 >> 2) * 128;
        bf16x8 b0 = *reinterpret_cast<const bf16x8*>(a);
        bf16x8 b1 = *reinterpret_cast<const bf16x8*>(a + 32 * 256);
        p0 = __builtin_amdgcn_mfma_f32_32x32x16_bf16(b0, qr[d0], p0, 0, 0, 0);
        p1 = __builtin_amdgcn_mfma_f32_32x32x16_bf16(b1, qr[d0], p1, 0, 0, 0); }
}
template <int VB, bool SK>
__device__ __forceinline__ void pv_tile(f32x16* o, int vb0, bf16x8 pa0, bf16x8 pa1, bf16x8 pa2, bf16x8 pa3, bool act) {
    if (SK && !act) return;
#define TRRD(dst, off) asm volatile("ds_read_b64_tr_b16 %0, %1 offset:%2" : "=&v"(dst) : "v"(vb0), "i"(off) : "memory")
#define PV_D0(d0) do { s16x4 l0, l1, l2, l3, h0, h1, h2, h3; constexpr int b_ = VB * SHM_V + v_rd_off(d0, 0, 0);     \
        TRRD(l0, b_); TRRD(h0, b_ + 2048); TRRD(l1, b_ + 4096); TRRD(h1, b_ + 6144); TRRD(l2, b_ + 8192); TRRD(h2, b_ + 10240); TRRD(l3, b_ + 12288); TRRD(h3, b_ + 14336); \
        asm volatile("s_waitcnt lgkmcnt(0)" ::: "memory"); SBAR();                 \
        o[d0] = __builtin_amdgcn_mfma_f32_32x32x16_bf16(pa0, (bf16x8){l0[0], l0[1], l0[2], l0[3], h0[0], h0[1], h0[2], h0[3]}, o[d0], 0, 0, 0);   \
        o[d0] = __builtin_amdgcn_mfma_f32_32x32x16_bf16(pa1, (bf16x8){l1[0], l1[1], l1[2], l1[3], h1[0], h1[1], h1[2], h1[3]}, o[d0], 0, 0, 0);   \
        o[d0] = __builtin_amdgcn_mfma_f32_32x32x16_bf16(pa2, (bf16x8){l2[0], l2[1], l2[2], l2[3], h2[0], h2[1], h2[2], h2[3]}, o[d0], 0, 0, 0);   \
        o[d0] = __builtin_amdgcn_mfma_f32_32x32x16_bf16(pa3, (bf16x8){l3[0], l3[1], l3[2], l3[3], h3[0], h3[1], h3[2], h3[3]}, o[d0], 0, 0, 0); } while (0)
    PV_D0(0); PV_D0(1); PV_D0(2); PV_D0(3);
#undef PV_D0
#undef TRRD
}
constexpr int ATT_KM_OFF = 2 * SHM_V + 2 * SHM_K + NW * 64 * 4, ATT_LUT_OFF = ATT_KM_OFF + 4096, ATT_LUT_N = 640, ATT_LDS_BYTES = ATT_LUT_OFF + ATT_LUT_N * 4;
constexpr int OSTR = 4096;
constexpr float OSCALE = 64.0f;
struct BlockRef { const bf16* Q; const bf16* K; const bf16* V; bf16* O; const float* KM; const float* BL; float* SSQ; int P0; };
struct Seam { bf16x8 qr[8]; bf16x8 st_v0, st_v1, st_k0, st_k1; };
#define ROW(p, k0, rr) ((p) + (size_t)((k0) + (rr)) * D + sc)
#define VMW() asm volatile("s_waitcnt vmcnt(0)" ::: "memory")
#define VMWN(n) asm volatile("s_waitcnt vmcnt(%0)" :: "i"(n) : "memory")
#define SLOAD_H(Kp, Vp, k0) do { S.st_v0 = load8<bf16>(ROW(Vp, k0, sr)); S.st_v1 = load8<bf16>(ROW(Vp, k0, 32 + sr));              \
                         S.st_k0 = load8<bf16>(ROW(Kp, k0, sr)); S.st_k1 = load8<bf16>(ROW(Kp, k0, 32 + sr)); } while (0)
#define SWRITE_HK(bf) do { *(bf16x8*)(K_lds + (bf) * SHM_K + kws) = S.st_k0; *(bf16x8*)(K_lds + (bf) * SHM_K + kws + 32 * 256) = S.st_k1; } while (0)
#define SWRITE_HV(bf) do { *(bf16x8*)(V_lds + (bf) * SHM_V + vst0) = S.st_v0; *(bf16x8*)(V_lds + (bf) * SHM_V + vst1) = S.st_v1; } while (0)
#define SWRITE_H(bf) do { SWRITE_HV(bf); SWRITE_HK(bf); } while (0)
__device__ __forceinline__ void moba_prime(const BlockRef& cur, char* lds, Seam& S) {
    const int tid = threadIdx.x, wid = __builtin_amdgcn_readfirstlane(tid >> 6), lane = tid & 63, r32 = lane & 31, hi = lane >> 5;
    const int sr = tid >> 4, sc = (tid & 15) * 8, kws = KSWZ(sr, sc * 2); char* K_lds = lds + 2 * SHM_V;
    for (int d0 = 0; d0 < 8; ++d0) S.qr[d0] = load8<bf16>(cur.Q + (size_t)(wid * QBLK + r32) * D + d0 * 16 + hi * 8);
    SLOAD_H(cur.K, cur.V, 0); VMW(); SWRITE_HK(0);
    __syncthreads();
}
__device__ __forceinline__ void add_tile(f32x16& p0, f32x16& p1, float a) {
#pragma unroll
    for (int r = 0; r < 16; ++r) { p0[r] += a; p1[r] += a; }
}
__device__ __forceinline__ void bias_tile(f32x16& p0, f32x16& p1, const ALAS float* lutp, float a) {
#pragma unroll
    for (int r = 0; r < 16; ++r) { const int c = (r & 3) + 8 * (r >> 2); p0[r] += lutp[c] + a; p1[r] += lutp[c + 32] + a; }
}
__device__ __forceinline__ void moba_block(const BlockRef& cur, const BlockRef& nxt, char* lds, ALAS unsigned char* ldsl, Seam& S) {
    int lane; asm volatile("v_mbcnt_lo_u32_b32 %0, -1, 0\n\tv_mbcnt_hi_u32_b32 %0, -1, %0" : "=v"(lane));
    const int wid = __builtin_amdgcn_readfirstlane(threadIdx.x >> 6), tid = wid * 64 + lane, r32 = lane & 31, hi = lane >> 5;
    const int NT = cur.P0 / KVBLK + 4;
    const int qblk = cur.P0 >> 8;
    const int qlo = cur.P0 + wid * QBLK, qm = qlo + r32 - 4 * hi;
    char* V_lds = lds; char* K_lds = lds + 2 * SHM_V;
    float* ws = (float*)(lds + 2 * SHM_V + 2 * SHM_K) + wid * 64; float* li_l = ws, * al_l = ws + 32;
    ALAS float* km_l = (ALAS float*)(ldsl + ATT_KM_OFF); ALAS float* lut_l = (ALAS float*)(ldsl + ATT_LUT_OFF);
    float m_reg = -1e30f, l_reg = 0; f32x16 o[4] = {};
    const int sr = tid >> 4, sc = (tid & 15) * 8, vst0 = v_st(sr, sc), vst1 = v_st(32 + sr, sc), kws = KSWZ(sr, sc * 2);
    const int vb0 = (int)(uintptr_t)V_lds + v_rd_base(lane);
    const bf16* Kh = cur.K; const bf16* Vh = cur.V;
    { const int tq = tid;
      if (tq < 256) *(ALAS f32x4*)(km_l + tq * 4) = *(const f32x4*)(cur.KM + tq * 4);
      for (int y = tq; y < ATT_LUT_N; y += 512) { int dist = 255 - y; dist = dist < 0 ? 0 : (dist > 127 ? 127 : dist); lut_l[y] = cur.BL[dist] * (1.0f / SCALE); } }
    const float b31 = cur.BL[127] * (1.0f / SCALE);
    __syncthreads();
    unsigned selmask = 0u;
    if (qblk > 0) {
        float gate[7];
#pragma unroll
        for (int j = 0; j < 7; ++j) {
            float g = 0.f;
            if (j < qblk) {
#pragma unroll
                for (int d0 = 0; d0 < 8; ++d0) { const f32x4 k0 = *(const ALAS f32x4*)(km_l + j * 128 + d0 * 16 + hi * 8), k1 = *(const ALAS f32x4*)(km_l + j * 128 + d0 * 16 + hi * 8 + 4);
                    const bf16x8 qv = S.qr[d0];
                    g += __uint_as_float(((unsigned)(unsigned short)qv[0]) << 16) * k0[0] + __uint_as_float(((unsigned)(unsigned short)qv[1]) << 16) * k0[1]
                       + __uint_as_float(((unsigned)(unsigned short)qv[2]) << 16) * k0[2] + __uint_as_float(((unsigned)(unsigned short)qv[3]) << 16) * k0[3]
                       + __uint_as_float(((unsigned)(unsigned short)qv[4]) << 16) * k1[0] + __uint_as_float(((unsigned)(unsigned short)qv[5]) << 16) * k1[1]
                       + __uint_as_float(((unsigned)(unsigned short)qv[6]) << 16) * k1[2] + __uint_as_float(((unsigned)(unsigned short)qv[7]) << 16) * k1[3]; }
                auto rr = __builtin_amdgcn_permlane32_swap(__float_as_uint(g), __float_as_uint(g), false, false);
                g = __uint_as_float(rr[0]) + __uint_as_float(rr[1]);
            }
            gate[j] = g;
        }
#pragma unroll
        for (int r = 0; r < 3; ++r) { if (r < qblk) { float best = 0.f; int bi = -1;
#pragma unroll
                for (int j = 0; j < 7; ++j) { if (j < qblk && !((selmask >> j) & 1u) && (bi < 0 || gate[j] > best)) { best = gate[j]; bi = j; } }
                selmask |= 1u << bi; } }
    }
#define RESC(a) do { if (__any((a) < 1.f)) { if (hi == 0) al_l[r32] = (a); asm volatile("s_waitcnt lgkmcnt(0)" ::: "memory");              \
                     for (int d_ = 0; d_ < 4; ++d_) for (int r = 0; r < 16; ++r) o[d_][r] *= al_l[crow(r, hi)]; } } while (0)
#define KBASE(t) ((t) * KVBLK)
#define MASKT(P0_, P1_, t) do { const int kb_ = KBASE(t); const int jb_ = kb_ >> 8; const bool near_ = (qlo - (kb_ + KVBLK - 1)) < 113;                              \
        const float sel_ = (jb_ == qblk || ((selmask >> jb_) & 1u)) ? 0.f : -__builtin_inff();                                                                     \
        if (near_) { int dq_ = qm - kb_; dq_ = dq_ < -260 ? -260 : dq_; bias_tile(P0_, P1_, lut_l + (255 - dq_), sel_); }              \
        else add_tile(P0_, P1_, sel_ + b31);                                                                                                                       \
        if (kb_ + KVBLK - 1 > qlo) mask_tile(P0_, P1_, qm - kb_, 0x7fffffffu); } while (0)
    constexpr int NQL = 8; constexpr bool SK = false;
#define SEAM_K0() do { VMWN(NQL); SWRITE_HK(0); SBAR(); } while (0)
    f32x16 pA0, pA1, pB0, pB1; float mnA, mnB, alA, alB; bf16x8 pa0, pa1, pa2, pa3;
    SWRITE_HV(0); SBAR();
    SLOAD_H(Kh, Vh, KBASE(1));
    SBAR(); qkt<0, SK>(pA0, pA1, K_lds, r32, hi, S.qr, true);
    MASKT(pA0, pA1, 0); partialSM(pA0, pA1, m_reg, mnA, alA);
    VMW(); SWRITE_H(1);
    __syncthreads();
#define HALF_STEP(PX0, PX1, mnX, alX, PY0, PY1, alY, t, KB, VB, SB) do {                                                      \
        SBAR(); qkt<KB, SK>(PX0, PX1, K_lds, r32, hi, S.qr, true);                                                            \
        finishSM(PY0, PY1, alY, l_reg, pa0, pa1, pa2, pa3); SBAR();                                                           \
        if ((t) + 1 < NT) { SLOAD_H(Kh, Vh, KBASE((t) + 1)); SBAR(); }                                                        \
        pv_tile<VB, SK>(o, vb0, pa0, pa1, pa2, pa3, true); MASKT(PX0, PX1, (t)); partialSM(PX0, PX1, m_reg, mnX, alX);        \
        __syncthreads();                                                                                                      \
        if ((t) + 1 < NT) { VMW(); SWRITE_H(SB); }                                                                            \
        RESC(alX); __syncthreads(); } while (0)
    for (int t = 1; t + 1 < NT; t += 2) {
        HALF_STEP(pB0, pB1, mnB, alB, pA0, pA1, alA, t, 1, 0, 0);
        HALF_STEP(pA0, pA1, mnA, alA, pB0, pB1, alB, t + 1, 0, 1, 1);
    }
    SBAR(); qkt<1, SK>(pB0, pB1, K_lds, r32, hi, S.qr, true); SBAR();
    SLOAD_H(nxt.K, nxt.V, 0); SBAR();
#pragma unroll
    for (int d0 = 0; d0 < 8; ++d0) S.qr[d0] = load8<bf16>(nxt.Q + (size_t)(wid * QBLK + r32) * D + d0 * 16 + hi * 8);
    SBAR();
    finishSM(pA0, pA1, alA, l_reg, pa0, pa1, pa2, pa3); SBAR();
    pv_tile<0, SK>(o, vb0, pa0, pa1, pa2, pa3, true);
    MASKT(pB0, pB1, NT - 1); partialSM(pB0, pB1, m_reg, mnB, alB); __syncthreads(); RESC(alB);
    finishSM(pB0, pB1, alB, l_reg, pa0, pa1, pa2, pa3); SBAR(); pv_tile<1, SK>(o, vb0, pa0, pa1, pa2, pa3, true);
    SBAR(); SEAM_K0();
    if (hi == 0) li_l[r32] = l_reg; asm volatile("s_waitcnt lgkmcnt(0)" ::: "memory");
    float rli[16];
#pragma unroll
    for (int r = 0; r < 16; ++r) rli[r] = __builtin_amdgcn_rcpf(li_l[crow(r, hi)]);
    {
        const __amdgpu_buffer_rsrc_t rO = __builtin_amdgcn_make_buffer_rsrc((void*)((unsigned char*)cur.O + (size_t)(wid * QBLK) * OSTR), (short)0, (int)(QBLK * OSTR), 0x00020000);
        const int voff = 4 * hi * OSTR + (r32 & 3) * 32 + (r32 & 28);
        const unsigned qi = (unsigned)(r32 & 3);
        const unsigned selA = qi | ((4u + qi) << 8) | 0x0c0c0000u, selB = 0x00000c0cu | (qi << 16) | ((4u + qi) << 24);
        float pr[16];
#pragma unroll
        for (int r = 0; r < 16; ++r) { const int rowb = ((r & 3) + 8 * (r >> 2)) * OSTR; float ps = 0.f; float vs[4];
#pragma unroll
            for (int d0 = 0; d0 < 4; ++d0) { const float v = o[d0][r] * rli[r]; ps += v * v; vs[d0] = __builtin_amdgcn_fmed3f(v * OSCALE, -448.f, 448.f); }
            int W = __builtin_amdgcn_cvt_pk_fp8_f32(vs[0], vs[1], 0, false); W = __builtin_amdgcn_cvt_pk_fp8_f32(vs[2], vs[3], W, true);
            const unsigned T0 = (unsigned)__builtin_amdgcn_mov_dpp(W, 0x00, 0xF, 0xF, true), T1 = (unsigned)__builtin_amdgcn_mov_dpp(W, 0x55, 0xF, 0xF, true);
            const unsigned T2 = (unsigned)__builtin_amdgcn_mov_dpp(W, 0xAA, 0xF, 0xF, true), T3 = (unsigned)__builtin_amdgcn_mov_dpp(W, 0xFF, 0xF, 0xF, true);
            const unsigned R = __builtin_amdgcn_perm(T1, T0, selA) | __builtin_amdgcn_perm(T3, T2, selB);
            __builtin_amdgcn_raw_buffer_store_b32(R, rO, voff, rowb, 0);
            pr[r] = ps; }
        float p8[8], p4[4], p2[2], p1;
        { const bool b = (r32 & 16) != 0;
#pragma unroll
          for (int i = 0; i < 8; ++i) { const float keep = b ? pr[i + 8] : pr[i], send = b ? pr[i] : pr[i + 8]; p8[i] = keep + __shfl_xor(send, 16); } }
        { const bool b = (r32 & 8) != 0;
#pragma unroll
          for (int i = 0; i < 4; ++i) { const float keep = b ? p8[i + 4] : p8[i], send = b ? p8[i] : p8[i + 4]; p4[i] = keep + __shfl_xor(send, 8); } }
        { const bool b = (r32 & 4) != 0;
#pragma unroll
          for (int i = 0; i < 2; ++i) { const float keep = b ? p4[i + 2] : p4[i], send = b ? p4[i] : p4[i + 2]; p2[i] = keep + __shfl_xor(send, 4); } }
        { const bool b = (r32 & 2) != 0; const float keep = b ? p2[1] : p2[0], send = b ? p2[0] : p2[1]; p1 = keep + __shfl_xor(send, 2); }
        p1 += __shfl_xor(p1, 1);
        { const int r = ((r32 >> 4) & 1) * 8 + ((r32 >> 3) & 1) * 4 + ((r32 >> 2) & 1) * 2 + ((r32 >> 1) & 1);
          if ((r32 & 1) == 0) atomicAdd(cur.SSQ + wid * QBLK + (r & 3) + 8 * (r >> 2) + 4 * hi, p1); }
    }
    __syncthreads();
#undef RESC
#undef KBASE
#undef MASKT
#undef SEAM_K0
#undef HALF_STEP
}
#undef ROW
#undef VMW
#undef VMWN
#undef SLOAD_H
#undef SWRITE_HK
#undef SWRITE_HV
#undef SWRITE_H
}
struct Args { const float* in[23]; float* out; unsigned char* ws; int ph_lo, ph_hi; };
struct Frame {
    LAS unsigned char* lds;
    volatile LAS unsigned* MISC;
    gu32* ctl;
    int tid, lane, wave;
    int vcu, G;
    float* out; unsigned char* ws;
};
enum { I_X = 0, I_GMIX, I_WIN, I_RELB, I_LRE, I_LIM, I_LDT, I_BRE, I_BIM, I_CRE, I_CIM, I_SD, I_WGLU, I_GATT, I_GSSM, I_WOUT, I_GFFN, I_WQ, I_KA, I_KB, I_PU, I_PV, I_GFIN };

struct TrDesc { const float* W; bf16* WT; const float* ks0; const float* ks1; int K, N, ksplit, item; float f8scale; int ldw; };
__device__ __forceinline__ void tr_load(const TrDesc& d, f32x4 (&v)[8], int lane) {
    const int nblk = d.N / 32, kb = d.item / nblk, nb = d.item % nblk, k0 = 64 * kb, n0 = 32 * nb;
#pragma unroll
    for (int i = 0; i < 8; ++i) { const int k = k0 + 8 * i + (lane >> 3);
        f32x4 t = *(const GAS f32x4*)(d.W + (size_t)k * d.ldw + n0 + (lane & 7) * 4);
        if (d.ks0) { const float sc = (k < d.ksplit) ? d.ks0[k] : d.ks1[k - d.ksplit]; t = t * sc; }
        v[i] = t; }
}
__device__ __forceinline__ void tr_store(const TrDesc& d, const f32x4 (&v)[8], LAS float* scr, int lane) {
    const int nblk = d.N / 32, kb = d.item / nblk, nb = d.item % nblk, k0 = 64 * kb, n0 = 32 * nb;
#pragma unroll
    for (int i = 0; i < 8; ++i) { LAS float* w = scr + (8 * i + (lane >> 3)) * 33 + (lane & 7) * 4; w[0] = v[i].x; w[1] = v[i].y; w[2] = v[i].z; w[3] = v[i].w; }
    LDS_WAIT(); asm volatile("" ::: "memory");
    const int c = lane & 7;
#pragma unroll
    for (int j = 0; j < 4; ++j) { const int n = (lane >> 3) + 8 * j; const LAS float* s = scr + (8 * c) * 33 + n;
        if (d.f8scale != 0.f) { const float q = d.f8scale; v2u o8; o8.x = pg8::pk4_fp8(s[0 * 33] * q, s[1 * 33] * q, s[2 * 33] * q, s[3 * 33] * q); o8.y = pg8::pk4_fp8(s[4 * 33] * q, s[5 * 33] * q, s[6 * 33] * q, s[7 * 33] * q);
            *(GAS v2u*)((unsigned char*)d.WT + (size_t)(n0 + n) * d.K + k0 + 8 * c) = o8; }
        else { v4u o; o.x = pk2(s[0 * 33], s[1 * 33]); o.y = pk2(s[2 * 33], s[3 * 33]); o.z = pk2(s[4 * 33], s[5 * 33]); o.w = pk2(s[6 * 33], s[7 * 33]);
            *(GAS v4u*)(d.WT + (size_t)(n0 + n) * d.K + k0 + 8 * c) = o; } }
    LDS_WAIT(); asm volatile("" ::: "memory");
}
__device__ __forceinline__ int t5_bucket(int n) {
    if (n < 16) return n;
    const float ratio = logf((float)n / 16.0f) / 2.0794415416798357f;
    int large = 16 + (int)(ratio * 16.0f);
    return large < 31 ? large : 31;
}
__device__ __forceinline__ void p0_prologue(Frame& F, const Args& A, int parts) {
    LAS float* scr = (LAS float*)(F.lds + RING_OFF + F.wave * 16384);
    const int gw = F.vcu * NWAVES + F.wave, NGW = F.G * NWAVES;
    bf16* Win_t = (bf16*)(F.ws + WS_WIN); bf16* Wglu_t = (bf16*)(F.ws + WS_WGLU); bf16* Wout_t = (bf16*)(F.ws + WS_WOUT); bf16* Wq_t = (bf16*)(F.ws + WS_WQ);
    constexpr int I_IN = (DM / 64) * (NSPLIT / 32), I_IN8 = (DM / 64) * ((NIN - NSPLIT) / 32), I_GL = (SW / 64) * (SW / 32), I_OUT = (DM / 64) * (DM / 32), I_Q = (DM / 64) * (2048 / 32);
    constexpr int NITEMS = I_IN + I_IN8 + I_GL + I_OUT + I_Q;
#define TR_DESC(d, it_) do { int r_ = (it_); \
        if (r_ < I_IN) { d = TrDesc{A.in[I_WIN], Win_t, nullptr, nullptr, DM, NSPLIT, 0, r_, 0.f, NIN}; } \
        else if ((r_ -= I_IN) < I_IN8) { d = TrDesc{A.in[I_WIN] + NSPLIT, (bf16*)(F.ws + WS_WIN8), nullptr, nullptr, DM, NIN - NSPLIT, 0, r_, pg8::FP8_SWI, NIN}; } \
        else if ((r_ -= I_IN8) < I_GL) { d = TrDesc{A.in[I_WGLU], Wglu_t, nullptr, nullptr, SW, SW, 0, r_, 0.f, SW}; } \
        else if ((r_ -= I_GL) < I_OUT) { d = TrDesc{A.in[I_WOUT], Wout_t, A.in[I_GATT], A.in[I_GSSM], DM, DM, AW, r_, pg8::FP8_SWO, DM}; } \
        else { r_ -= I_OUT; d = TrDesc{A.in[I_WQ], Wq_t, A.in[I_GFFN], A.in[I_GFFN], DM, 2048, DM, r_, pg8::FP8_SWQ, 2048}; } } while (0)
    const int it_lo = (parts & 4) ? 0 : I_IN + I_IN8, it_hi = (parts & 1) ? NITEMS : I_IN + I_IN8;
    for (int it = it_lo + gw; it < it_hi; it += 2 * NGW) {
        const int itb = it + NGW; const bool hb = itb < it_hi;
        TrDesc da, db; TR_DESC(da, it); TR_DESC(db, hb ? itb : it);
        f32x4 va[8], vb[8];
        tr_load(da, va, F.lane); tr_load(db, vb, F.lane);
        tr_store(da, va, scr, F.lane);
        if (hb) tr_store(db, vb, scr, F.lane);
    }
#undef TR_DESC
    if (parts & 2) {
        bf16* Hb = (bf16*)(F.ws + WS_H); const float* x = A.in[I_X]; const GAS f32x4* gp = (const GAS f32x4*)A.in[I_GMIX] + F.lane;
        f32x4 gg[16];
#pragma unroll
        for (int j = 0; j < 16; ++j) gg[j] = gp[64 * j];
        for (int m = gw; m < T; m += NGW) {
            const GAS f32x4* xr = (const GAS f32x4*)(x + (size_t)m * DM) + F.lane;
            f32x4 v[16]; float s = 0.f;
#pragma unroll
            for (int j = 0; j < 16; ++j) { v[j] = xr[64 * j]; s += (v[j].x * v[j].x + v[j].y * v[j].y) + (v[j].z * v[j].z + v[j].w * v[j].w); }
            const float r = 1.0f / sqrtf(wave_sum(s) * (1.0f / DM) + RMS_EPS);
            GAS v2u* o8 = (GAS v2u*)(Hb + (size_t)m * DM) + F.lane; GAS unsigned* h8 = (GAS unsigned*)(F.ws + WS_H8 + (size_t)m * DM) + F.lane;
#pragma unroll
            for (int j = 0; j < 16; ++j) { const f32x4 g = gg[j]; const float h0 = v[j].x * r * g.x, h1 = v[j].y * r * g.y, h2 = v[j].z * r * g.z, h3 = v[j].w * r * g.w;
                v2u w; w.x = pk2(h0, h1); w.y = pk2(h2, h3); o8[64 * j] = w;
                h8[64 * j] = pg8::pk4_fp8(h0 * pg8::FP8_SH, h1 * pg8::FP8_SH, h2 * pg8::FP8_SH, h3 * pg8::FP8_SH); }
        }
    }
    if (parts & 1) {
        bf16* Kb = (bf16*)(F.ws + WS_KEYS); const int gt = (F.vcu * NWAVES + F.wave) * 64 + F.lane, NT_ = F.G * NWAVES * 64;
        for (int i = gt; i < 2 * PH * PK * 128; i += NT_) { const float v = i < PH * PK * 128 ? A.in[I_KA][i] : A.in[I_KB][i - PH * PK * 128]; Kb[i] = (bf16)f2bf(v); }
        float* bl = (float*)(F.ws + WS_BLUT);
        for (int i = gt; i < NH * 128; i += NT_) { const int h = i >> 7, d = i & 127; bl[i] = A.in[I_RELB][t5_bucket(d) * NH + h]; }
    }
}

__device__ __forceinline__ void ssm_naive_item(Frame& F, const Args& A, int item) {
    const int b = item >> 7, g = item & 127; const int tid = F.tid;
    LAS float* L = (LAS float*)(F.lds + RING_OFF);
    LAS float* Bre = L;
    LAS float* Bim = Bre + 64 * 17;
    LAS float* Cre = Bim + 64 * 17;
    LAS float* Cim = Cre + 16 * 65;
    LAS float* Are = Cim + 16 * 65;
    LAS float* Aim = Are + 64;
    LAS float* Hb = Aim + 64;
    LAS unsigned short* Ul = (LAS unsigned short*)(Hb + 2 * 16 * 129 + 4);
    const bf16* ub = (const bf16*)(F.ws + WS_U); bf16* yg = (bf16*)(F.ws + WS_YG);
    __syncthreads();
    if (tid < 64) {
        const int p = tid; const float lre = A.in[I_LRE][g * 64 + p], lim = A.in[I_LIM][g * 64 + p];
        const double dt = exp((double)A.in[I_LDT][g]);
        const double mag = exp((double)lre * dt); const double ph = (double)lim * dt;
        const double kk = rint(ph / 6.283185307179586476925); const float phr = (float)(ph - kk * 6.283185307179586476925);
        const float are = (float)mag * cosf(phr), aim = (float)mag * sinf(phr);
        Are[p] = are; Aim[p] = aim;
        const float den = lre * lre + lim * lim; const float nr = are - 1.0f, ni = aim;
        const float cre = (nr * lre + ni * lim) / den, cim = (ni * lre - nr * lim) / den;
#pragma unroll
        for (int c = 0; c < 16; ++c) { const float br = A.in[I_BRE][(g * 64 + p) * 16 + c], bi = A.in[I_BIM][(g * 64 + p) * 16 + c];
            Bre[p * 17 + c] = cre * br - cim * bi; Bim[p * 17 + c] = cre * bi + cim * br; }
    }
    for (int i = tid; i < 1024; i += 512) { const int c = i >> 6, p = i & 63; Cre[c * 65 + p] = A.in[I_CRE][(g * 16 + c) * 64 + p]; Cim[c * 65 + p] = A.in[I_CIM][(g * 16 + c) * 64 + p]; }
    for (int i = tid; i < 4096; i += 512) { const int t = i >> 1, hf = i & 1; const v4u w = *(const GAS v4u*)(ub + (size_t)(b * SEQ + t) * 2048 + g * 16 + hf * 8); *(LAS v4u*)(Ul + t * 16 + hf * 8) = w; }
    __syncthreads();
    float hre = 0.f, him = 0.f;
    const float are = (tid >= 448) ? Are[tid - 448] : 0.f, aim = (tid >= 448) ? Aim[tid - 448] : 0.f;
    for (int ck = 0; ck <= 128; ++ck) {
        if (tid >= 448 && ck < 128) {
            const int p = tid - 448; LAS float* hb = Hb + (ck & 1) * 16 * 129;
            for (int s = 0; s < 16; ++s) { const int t = ck * 16 + s; float bur = 0.f, bui = 0.f;
#pragma unroll
                for (int c = 0; c < 16; ++c) { const float uv = bf2f(Ul[t * 16 + c]); bur += Bre[p * 17 + c] * uv; bui += Bim[p * 17 + c] * uv; }
                const float nre = are * hre - aim * him + bur, nim = are * him + aim * hre + bui; hre = nre; him = nim;
                hb[s * 129 + p] = hre; hb[s * 129 + 64 + p] = him; }
        }
        if (tid < 256 && ck > 0) {
            const int s = tid >> 4, c = tid & 15; const LAS float* hb = Hb + ((ck - 1) & 1) * 16 * 129 + s * 129; float y = 0.f;
#pragma unroll 8
            for (int p = 0; p < 64; ++p) y += Cre[c * 65 + p] * hb[p] - Cim[c * 65 + p] * hb[64 + p];
            const int t = (ck - 1) * 16 + s; const float uv = bf2f(Ul[t * 16 + c]);
            y += A.in[I_SD][g * 16 + c] * uv;
            yg[(size_t)(b * SEQ + t) * SW + g * 16 + c] = (bf16)f2bf(gelu_erf(y));
        }
        __syncthreads();
    }
}
__device__ __forceinline__ void kmean_item(Frame& F, int item) {
    const int bh = item >> 3, blk = item & 7; const int tid = F.tid, kg = tid >> 4, c = tid & 15;
    const bf16* kb = (const bf16*)(F.ws + WS_QKV) + (size_t)T * 2048 + ((size_t)bh * SEQ + blk * 256 + kg * 8) * HD + c * 8;
    LAS float* L = (LAS float*)(F.lds + RING_OFF);
    v4u w[8];
#pragma unroll
    for (int i = 0; i < 8; ++i) w[i] = *(const GAS v4u*)(kb + (size_t)i * HD);
    float s[8] = {0.f, 0.f, 0.f, 0.f, 0.f, 0.f, 0.f, 0.f};
#pragma unroll
    for (int i = 0; i < 8; ++i) { s[0] += bflo(w[i].x); s[1] += bfhi(w[i].x); s[2] += bflo(w[i].y); s[3] += bfhi(w[i].y); s[4] += bflo(w[i].z); s[5] += bfhi(w[i].z); s[6] += bflo(w[i].w); s[7] += bfhi(w[i].w); }
    __syncthreads();
    *(LAS f32x4*)(L + kg * 128 + c * 8) = (f32x4){s[0], s[1], s[2], s[3]}; *(LAS f32x4*)(L + kg * 128 + c * 8 + 4) = (f32x4){s[4], s[5], s[6], s[7]};
    __syncthreads();
    if (tid < 128) { float a = 0.f;
#pragma unroll 8
        for (int g = 0; g < 32; ++g) a += L[g * 128 + tid];
        ((float*)(F.ws + WS_KMEAN))[(size_t)item * 128 + tid] = a * (1.0f / 256.0f); }
}

__device__ __forceinline__ void attn_naive_item(Frame& F, int item) {
    const int bh = item >> 8, rg = item & 255; const int b = bh >> 4, h = bh & 15;
    const int s = rg * 8 + F.wave, qblk = s >> 8, lane = F.lane;
    const bf16* qb = (const bf16*)(F.ws + WS_QKV) + ((size_t)bh * SEQ + s) * HD;
    const bf16* kb = (const bf16*)(F.ws + WS_QKV) + (size_t)T * 2048 + (size_t)bh * SEQ * HD;
    const bf16* vb = (const bf16*)(F.ws + WS_QKV) + (size_t)2 * T * 2048 + (size_t)bh * SEQ * HD;
    const float* km = (const float*)(F.ws + WS_KMEAN) + (size_t)bh * 8 * 128;
    const float* bl = (const float*)(F.ws + WS_BLUT) + h * 128;
    LAS float* qs = (LAS float*)(F.lds + RING_OFF) + F.wave * 128;
    const float q0 = bf2f(qb[lane]), q1 = bf2f(qb[lane + 64]);
    qs[lane] = q0; qs[lane + 64] = q1;
    float gate[7];
#pragma unroll
    for (int j = 0; j < 7; ++j) { float gsum = 0.f; if (j < qblk) gsum = wave_sum(q0 * km[j * 128 + lane] + q1 * km[j * 128 + lane + 64]); gate[j] = (j < qblk) ? gsum : -3.0e38f; }
    unsigned selmask = 0u;
#pragma unroll
    for (int r = 0; r < 3; ++r) { if (r < qblk) { float best = 0.f; int bi = -1;
#pragma unroll
            for (int j = 0; j < 7; ++j) { if (j < qblk && !((selmask >> j) & 1u) && (bi < 0 || gate[j] > best)) { best = gate[j]; bi = j; } }
            selmask |= 1u << bi; } }
    unsigned blocks = selmask | (1u << qblk);
    const int nslots = __popc(blocks);
    LDS_WAIT();
    float sc[4][4]; int sj[4];
    const float scale = 0.08838834764831845f;
#pragma unroll
    for (int sl = 0; sl < 4; ++sl) {
        int j = 0; if (sl < nslots) { j = __ffs(blocks) - 1; blocks &= blocks - 1; } sj[sl] = j;
#pragma unroll
        for (int i = 0; i < 4; ++i) {
            float v = -__builtin_inff();
            if (sl < nslots) {
                const int key = j * 256 + i * 64 + lane; const GAS v4u* kr = (const GAS v4u*)(kb + (size_t)key * HD); float dot = 0.f;
#pragma unroll 4
                for (int c = 0; c < 16; ++c) { const v4u w = kr[c]; const LAS f32x4* qv = (const LAS f32x4*)(qs + c * 8); const f32x4 qa = qv[0], qb4 = qv[1];
                    dot += bflo(w.x) * qa.x + bfhi(w.x) * qa.y + bflo(w.y) * qa.z + bfhi(w.y) * qa.w + bflo(w.z) * qb4.x + bfhi(w.z) * qb4.y + bflo(w.w) * qb4.z + bfhi(w.w) * qb4.w; }
                const int dist = s - key;
                if (dist >= 0) v = dot * scale + bl[dist < 127 ? dist : 127];
            }
            sc[sl][i] = v;
        }
    }
    float mx = -__builtin_inff();
#pragma unroll
    for (int sl = 0; sl < 4; ++sl)
#pragma unroll
        for (int i = 0; i < 4; ++i) mx = fmaxf(mx, sc[sl][i]);
    mx = wave_max(mx);
    float sum = 0.f;
#pragma unroll
    for (int sl = 0; sl < 4; ++sl)
#pragma unroll
        for (int i = 0; i < 4; ++i) { const float p = __builtin_amdgcn_exp2f((sc[sl][i] - mx) * LOG2E); sc[sl][i] = p; sum += p; }
    sum = wave_sum(sum);
    float o0 = 0.f, o1 = 0.f;
#pragma unroll
    for (int sl = 0; sl < 4; ++sl) {
        if (sl < nslots) {
#pragma unroll
            for (int i = 0; i < 4; ++i) {
                const bf16* vr = vb + (size_t)(sj[sl] * 256 + i * 64) * HD + lane;
                const float pv = sc[sl][i];
#pragma unroll 8
                for (int l = 0; l < 64; ++l) { const float p = __int_as_float(__builtin_amdgcn_readlane(__float_as_int(pv), l));
                    o0 += p * bf2f(vr[(size_t)l * HD]); o1 += p * bf2f(vr[(size_t)l * HD + 64]); }
            }
        }
    }
    const float inv = 1.0f / sum; o0 *= inv; o1 *= inv;
    const int token = b * SEQ + s;
    bf16* yc = (bf16*)(F.ws + WS_YCAT) + (size_t)token * DM + h * HD;
    yc[lane] = (bf16)f2bf(o0); yc[lane + 64] = (bf16)f2bf(o1);
    const float ss = wave_sum(o0 * o0 + o1 * o1);
    if (lane == 0) atomicAdd((float*)(F.ctl + CW_SSQA) + token, ss);
    LDS_WAIT();
}

__device__ __forceinline__ void ynorm_phase(Frame& F) {
    const int gw = F.vcu * NWAVES + F.wave, NGW = F.G * NWAVES;
    bf16* yc = (bf16*)(F.ws + WS_YCAT);
    for (int m = gw; m < T; m += NGW) {
        GAS v4u* p = (GAS v4u*)(yc + (size_t)m * DM) + F.lane;
        v4u w[8]; float sa = 0.f, ss = 0.f;
#pragma unroll
        for (int j = 0; j < 8; ++j) { w[j] = p[64 * j];
            const float q = (bflo(w[j].x) * bflo(w[j].x) + bfhi(w[j].x) * bfhi(w[j].x)) + (bflo(w[j].y) * bflo(w[j].y) + bfhi(w[j].y) * bfhi(w[j].y))
                          + (bflo(w[j].z) * bflo(w[j].z) + bfhi(w[j].z) * bfhi(w[j].z)) + (bflo(w[j].w) * bflo(w[j].w) + bfhi(w[j].w) * bfhi(w[j].w));
            if (j < 4) sa += q; else ss += q; }
        const float ra = 1.0f / sqrtf(wave_sum(sa) * (1.0f / AW) + RMS_EPS);
        const float rs = 1.0f / sqrtf(wave_sum(ss) * (1.0f / SW) + RMS_EPS);
#pragma unroll
        for (int j = 0; j < 8; ++j) { const float r = j < 4 ? ra : rs; v4u o;
            o.x = pk2(bflo(w[j].x) * r, bfhi(w[j].x) * r); o.y = pk2(bflo(w[j].y) * r, bfhi(w[j].y) * r); o.z = pk2(bflo(w[j].z) * r, bfhi(w[j].z) * r); o.w = pk2(bflo(w[j].w) * r, bfhi(w[j].w) * r);
            p[64 * j] = o; }
    }
}

__device__ __forceinline__ void topk_naive_phase(Frame& F) {
    const int gw = F.vcu * NWAVES + F.wave, NGW = F.G * NWAVES, lane = F.lane;
    const bf16* qp = (const bf16*)(F.ws + WS_QP); const bf16* keys = (const bf16*)(F.ws + WS_KEYS);
    int* ex = (int*)(F.ws + WS_EXP); float* gt = (float*)(F.ws + WS_GATE);
    LAS float* qs = (LAS float*)(F.lds + RING_OFF) + F.wave * 256;
    for (int it = gw; it < T * PH; it += NGW) {
        const int tok = it >> 3, h = it & 7;
        { const v2u w = *(const GAS v2u*)(qp + (size_t)tok * 2048 + h * 256 + lane * 4); qs[lane * 4 + 0] = bflo(w.x); qs[lane * 4 + 1] = bfhi(w.x); qs[lane * 4 + 2] = bflo(w.y); qs[lane * 4 + 3] = bfhi(w.y); }
        LDS_WAIT();
        float sv[2][2];
#pragma unroll
        for (int side = 0; side < 2; ++side)
#pragma unroll
            for (int kk = 0; kk < 2; ++kk) {
                const GAS v4u* kr = (const GAS v4u*)(keys + ((size_t)(side * PH + h) * PK + kk * 64 + lane) * 128); float dot = 0.f;
#pragma unroll 4
                for (int c = 0; c < 16; ++c) { const v4u w = kr[c]; const LAS f32x4* qv = (const LAS f32x4*)(qs + side * 128 + c * 8); const f32x4 qa = qv[0], qb4 = qv[1];
                    dot += bflo(w.x) * qa.x + bfhi(w.x) * qa.y + bflo(w.y) * qa.z + bfhi(w.y) * qa.w + bflo(w.z) * qb4.x + bfhi(w.z) * qb4.y + bflo(w.w) * qb4.z + bfhi(w.w) * qb4.w; }
                sv[side][kk] = dot;
            }
        float tv[2]; int ti[2];
#pragma unroll
        for (int side = 0; side < 2; ++side) {
            float v0 = sv[side][0], v1 = sv[side][1]; float keepv = 0.f; int keepi = 0;
            for (int r = 0; r < 16; ++r) {
                float bv = v0 >= v1 ? v0 : v1; int bi = v0 >= v1 ? lane : lane + 64;
#pragma unroll
                for (int o = 1; o < 64; o <<= 1) { const float ov = __shfl_xor(bv, o); const int oi = __shfl_xor(bi, o); if (ov > bv || (ov == bv && oi < bi)) { bv = ov; bi = oi; } }
                if (lane == r) { keepv = bv; keepi = bi; }
                if (bi == lane) v0 = -__builtin_inff(); if (bi == lane + 64) v1 = -__builtin_inff();
            }
            tv[side] = keepv; ti[side] = keepi;
        }
        float cv[4];
        { const float vai = __shfl(tv[0], lane >> 2);
#pragma unroll
          for (int m = 0; m < 4; ++m) cv[m] = vai + __shfl(tv[1], (lane & 3) * 4 + m); }
        float bestv = 0.f; int bestc = 0;
        for (int r = 0; r < 16; ++r) {
            float bv = cv[0]; int bi = lane * 4;
#pragma unroll
            for (int m = 1; m < 4; ++m) if (cv[m] > bv) { bv = cv[m]; bi = lane * 4 + m; }
#pragma unroll
            for (int o = 1; o < 64; o <<= 1) { const float ov = __shfl_xor(bv, o); const int oi = __shfl_xor(bi, o); if (ov > bv || (ov == bv && oi < bi)) { bv = ov; bi = oi; } }
            if (lane == r) { bestv = bv; bestc = bi; }
#pragma unroll
            for (int m = 0; m < 4; ++m) if (bi == lane * 4 + m) cv[m] = -__builtin_inff();
        }
        const float vmax = __shfl(bestv, 0);
        const float ev = lane < 16 ? __builtin_amdgcn_exp2f((bestv - vmax) * LOG2E) : 0.f;
        const float esum = wave_sum(ev);
        const int ea = __shfl(ti[0], bestc >> 4), eb = __shfl(ti[1], bestc & 15);
        if (lane < 16) { ex[(size_t)tok * PSEL + h * 16 + lane] = ea * PK + eb; gt[(size_t)tok * PSEL + h * 16 + lane] = ev / esum; }
    }
}

__device__ __forceinline__ att::BlockRef attn_ref(Frame& F, int L, int pass) {
    const int bh = L >> 2, x = L & 3, qb = pass ? 7 - x : x; const int b = bh >> 4, h = bh & 15;
    att::BlockRef r;
    const bf16* base = (const bf16*)(F.ws + WS_QKV);
    r.Q = base + ((size_t)bh * SEQ + qb * 256) * HD;
    r.K = base + (size_t)T * 2048 + (size_t)bh * SEQ * HD;
    r.V = base + (size_t)2 * T * 2048 + (size_t)bh * SEQ * HD;
    r.O = (bf16*)(F.ws + WS_YCAT + ((size_t)(b * SEQ + qb * 256)) * DM + h * HD);
    r.KM = (const float*)(F.ws + WS_KMEAN) + (size_t)bh * 1024;
    r.BL = (const float*)(F.ws + WS_BLUT) + h * 128;
    r.SSQ = (float*)(F.ctl + CW_SSQAT) + (b * SEQ + qb * 256);
    r.P0 = qb * 256;
    return r;
}
__device__ __forceinline__ void attn_mfma_phase(Frame& F, unsigned char* ldsg) {
    const int total = BATCH * NH * 4, stride = F.G;
    int L = F.vcu; if (L >= total) return;
    int pass = 0;
    att::BlockRef cur = attn_ref(F, L, 0);
    att::Seam S;
    att::moba_prime(cur, (char*)ldsg + RING_OFF, S);
    for (;;) {
        const bool more_pass = pass == 0, more_item = L + stride < total, last = !more_pass && !more_item;
        int passn = pass + 1, Ln = L;
        if (!more_pass) { passn = 0; Ln = more_item ? L + stride : L; }
        const att::BlockRef nxt = last ? cur : attn_ref(F, Ln, passn);
        att::moba_block(cur, nxt, (char*)ldsg + RING_OFF, F.lds + RING_OFF, S);
        if (last) break;
        cur = nxt; pass = passn; L = Ln;
    }
}
typedef short tk_bf16x8 __attribute__((ext_vector_type(8)));
typedef float tk_f32x16 __attribute__((ext_vector_type(16)));
__device__ __forceinline__ unsigned ordkey(float v) { const unsigned u = __float_as_uint(v); return u ^ ((unsigned)((int)u >> 31) | 0x80000000u); }
__device__ __forceinline__ float ordval(unsigned k) { const unsigned u = (k & 0x80000000u) ? (k ^ 0x80000000u) : ~k; return __uint_as_float(u); }
#define TK_INSERT(lst, key) do { unsigned nk_ = (key); _Pragma("unroll") for (int q_ = 0; q_ < 16; ++q_) { const unsigned hi_ = lst[q_] > nk_ ? lst[q_] : nk_; nk_ = lst[q_] > nk_ ? nk_ : lst[q_]; lst[q_] = hi_; } } while (0)
#define TK_CE(a, b) do { const unsigned hi_ = (a) > (b) ? (a) : (b); const unsigned lo_ = (a) > (b) ? (b) : (a); (a) = hi_; (b) = lo_; } while (0)
__device__ __forceinline__ void tk_bitonic_merge16(unsigned (&x)[16]) {
    TK_CE(x[0], x[8]); TK_CE(x[1], x[9]); TK_CE(x[2], x[10]); TK_CE(x[3], x[11]); TK_CE(x[4], x[12]); TK_CE(x[5], x[13]); TK_CE(x[6], x[14]); TK_CE(x[7], x[15]); TK_CE(x[0], x[4]); TK_CE(x[1], x[5]); TK_CE(x[2], x[6]); TK_CE(x[3], x[7]); TK_CE(x[8], x[12]); TK_CE(x[9], x[13]); TK_CE(x[10], x[14]); TK_CE(x[11], x[15]); TK_CE(x[0], x[2]); TK_CE(x[1], x[3]); TK_CE(x[4], x[6]); TK_CE(x[5], x[7]); TK_CE(x[8], x[10]); TK_CE(x[9], x[11]); TK_CE(x[12], x[14]); TK_CE(x[13], x[15]); TK_CE(x[0], x[1]); TK_CE(x[2], x[3]); TK_CE(x[4], x[5]); TK_CE(x[6], x[7]); TK_CE(x[8], x[9]); TK_CE(x[10], x[11]); TK_CE(x[12], x[13]); TK_CE(x[14], x[15]);
}
__device__ __forceinline__ void tk_sort16(unsigned (&x)[16]) {
    TK_CE(x[0], x[1]); TK_CE(x[3], x[2]); TK_CE(x[4], x[5]); TK_CE(x[7], x[6]); TK_CE(x[8], x[9]); TK_CE(x[11], x[10]); TK_CE(x[12], x[13]); TK_CE(x[15], x[14]); TK_CE(x[0], x[2]); TK_CE(x[1], x[3]); TK_CE(x[6], x[4]); TK_CE(x[7], x[5]); TK_CE(x[8], x[10]); TK_CE(x[9], x[11]); TK_CE(x[14], x[12]); TK_CE(x[15], x[13]); TK_CE(x[0], x[1]); TK_CE(x[2], x[3]); TK_CE(x[5], x[4]); TK_CE(x[7], x[6]); TK_CE(x[8], x[9]); TK_CE(x[10], x[11]); TK_CE(x[13], x[12]); TK_CE(x[15], x[14]); TK_CE(x[0], x[4]); TK_CE(x[1], x[5]); TK_CE(x[2], x[6]); TK_CE(x[3], x[7]); TK_CE(x[12], x[8]); TK_CE(x[13], x[9]); TK_CE(x[14], x[10]); TK_CE(x[15], x[11]); TK_CE(x[0], x[2]); TK_CE(x[1], x[3]); TK_CE(x[4], x[6]); TK_CE(x[5], x[7]); TK_CE(x[10], x[8]); TK_CE(x[11], x[9]); TK_CE(x[14], x[12]); TK_CE(x[15], x[13]); TK_CE(x[0], x[1]); TK_CE(x[2], x[3]); TK_CE(x[4], x[5]); TK_CE(x[6], x[7]); TK_CE(x[9], x[8]); TK_CE(x[11], x[10]); TK_CE(x[13], x[12]); TK_CE(x[15], x[14]); TK_CE(x[0], x[8]); TK_CE(x[1], x[9]); TK_CE(x[2], x[10]); TK_CE(x[3], x[11]); TK_CE(x[4], x[12]); TK_CE(x[5], x[13]); TK_CE(x[6], x[14]); TK_CE(x[7], x[15]); TK_CE(x[0], x[4]); TK_CE(x[1], x[5]); TK_CE(x[2], x[6]); TK_CE(x[3], x[7]); TK_CE(x[8], x[12]); TK_CE(x[9], x[13]); TK_CE(x[10], x[14]); TK_CE(x[11], x[15]); TK_CE(x[0], x[2]); TK_CE(x[1], x[3]); TK_CE(x[4], x[6]); TK_CE(x[5], x[7]); TK_CE(x[8], x[10]); TK_CE(x[9], x[11]); TK_CE(x[12], x[14]); TK_CE(x[13], x[15]); TK_CE(x[0], x[1]); TK_CE(x[2], x[3]); TK_CE(x[4], x[5]); TK_CE(x[6], x[7]); TK_CE(x[8], x[9]); TK_CE(x[10], x[11]); TK_CE(x[12], x[13]); TK_CE(x[14], x[15]);
}
__device__ __forceinline__ void tk_top16_merge(unsigned (&a)[16], const unsigned (&b)[16]) {
#pragma unroll
    for (int i = 0; i < 16; ++i) a[i] = a[i] > b[15 - i] ? a[i] : b[15 - i];
    tk_bitonic_merge16(a);
}
__device__ __forceinline__ void topk_mfma_item(Frame& F, int item, bool stage_keys = true) {
    const int tile = item >> 3, head = item & 7, tok0 = tile * 128; int tid = F.tid; asm volatile("" : "+v"(tid));
    const int lane = tid & 63, wave = F.wave;
    const bf16* qp = (const bf16*)(F.ws + WS_QP); const bf16* keys = (const bf16*)(F.ws + WS_KEYS);
    LAS unsigned* lists = (LAS unsigned*)(F.lds + RING_OFF);
    LAS unsigned char* KL2 = F.lds + RING_OFF + 32768;
    __syncthreads();
    if (stage_keys) {
#pragma unroll
        for (int i = 0; i < 8; ++i) { const int c = tid + 512 * i, sd = c >> 11, key = (c >> 4) & 127, ch = c & 15;
            *(LAS v4u*)(KL2 + (sd * 128 + key) * 272 + ch * 16) = *(const GAS v4u*)(keys + ((size_t)(sd * PH + head) * PK + key) * 128 + ch * 8); }
        __syncthreads();
    }
    unsigned lst[16];
    {
        const int side = wave >> 2, rt = wave & 3, r = lane & 31, hk = lane >> 5;
        tk_bf16x8 a[8];
        const bf16* ap = qp + (size_t)(tok0 + rt * 32 + r) * 2048 + head * 256 + side * 128 + hk * 8;
#pragma unroll
        for (int ks = 0; ks < 8; ++ks) a[ks] = *(const GAS tk_bf16x8*)(ap + ks * 16);
#pragma unroll
        for (int ct = 0; ct < 4; ++ct) {
            const LAS unsigned char* bp = KL2 + (side * 128 + ct * 32 + r) * 272 + hk * 16;
            tk_bf16x8 b[8];
#pragma unroll
            for (int ks = 0; ks < 8; ++ks) b[ks] = *(const LAS tk_bf16x8*)(bp + ks * 32);
            tk_f32x16 acc = {};
#pragma unroll
            for (int ks = 0; ks < 8; ++ks) acc = __builtin_amdgcn_mfma_f32_32x32x16_bf16(b[ks], a[ks], acc, 0, 0, 0);
            unsigned g[16];
#pragma unroll
            for (int rg = 0; rg < 16; ++rg) { const int j = ct * 32 + (rg & 3) + 8 * (rg >> 2) + 4 * hk; g[rg] = (ordkey(acc[rg]) & ~127u) | (unsigned)(127 - j); }
            tk_sort16(g);
            if (ct == 0) {
#pragma unroll
                for (int q = 0; q < 16; ++q) lst[q] = g[q]; }
            else tk_top16_merge(lst, g);
            __builtin_amdgcn_sched_barrier(0); }
        unsigned oth[16];
#pragma unroll
        for (int q = 0; q < 16; ++q) { const auto rr = __builtin_amdgcn_permlane32_swap(lst[q], lst[q], false, false); oth[q] = hk ? rr[0] : rr[1]; }
        tk_top16_merge(lst, oth);
        if (hk == 0) {
#pragma unroll
            for (int q = 0; q < 16; ++q) lists[(side * 128 + rt * 32 + r) * 17 + q] = lst[q]; }
    }
    __syncthreads();
    const int row = tid & 127;
    if (tid < 128) {
        float va[16], vb[16];
#pragma unroll
        for (int q = 0; q < 16; ++q) { va[q] = ordval(lists[row * 17 + q] & ~127u); vb[q] = ordval(lists[(128 + row) * 17 + q] & ~127u); }
        unsigned cl[16], g1[16], g2[16], g3[16];
#define TK_CAND(i, j) ((ordkey(va[i] + vb[j]) & ~255u) | (unsigned)(255 - ((i) * 16 + (j))))
#pragma unroll
        for (int j = 0; j < 16; ++j) cl[j] = TK_CAND(0, j);
#pragma unroll
        for (int j = 0; j < 8; ++j) g1[j] = TK_CAND(1, j);
#pragma unroll
        for (int j = 0; j < 5; ++j) g1[8 + j] = TK_CAND(2, j);
        g1[13] = TK_CAND(5, 0); g1[14] = TK_CAND(5, 1); g1[15] = 0u;
#pragma unroll
        for (int j = 0; j < 4; ++j) g2[j] = TK_CAND(3, j);
#pragma unroll
        for (int j = 0; j < 3; ++j) g2[4 + j] = TK_CAND(4, j);
        g2[7] = TK_CAND(6, 0); g2[8] = TK_CAND(6, 1); g2[9] = TK_CAND(7, 0); g2[10] = TK_CAND(7, 1);
#pragma unroll
        for (int j = 11; j < 16; ++j) g2[j] = 0u;
#pragma unroll
        for (int i = 0; i < 8; ++i) { g3[i] = TK_CAND(8 + i, 0); g3[8 + i] = 0u; }
#undef TK_CAND
        tk_sort16(g1); tk_sort16(g2);
        tk_top16_merge(cl, g1); tk_top16_merge(g2, g3); tk_top16_merge(cl, g2);
        const float vmax = ordval(cl[0] & ~255u);
        float ev[16]; float es = 0.f; int ee[16];
#pragma unroll
        for (int q = 0; q < 16; ++q) { ev[q] = __builtin_amdgcn_exp2f((ordval(cl[q] & ~255u) - vmax) * LOG2E); es += ev[q];
            const int c = 255 - (int)(cl[q] & 255u); const int ia = 127 - (int)(lists[row * 17 + (c >> 4)] & 127u), ib = 127 - (int)(lists[(128 + row) * 17 + (c & 15)] & 127u);
            ee[q] = ia * PK + ib; }
        const float inv = 1.0f / es;
        int* ex = (int*)(F.ws + WS_EXP) + (size_t)(tok0 + row) * PSEL + head * 16; float* gt = (float*)(F.ws + WS_GATE) + (size_t)(tok0 + row) * PSEL + head * 16;
#pragma unroll
        for (int q = 0; q < 4; ++q) { *(GAS v4u*)(ex + q * 4) = (v4u){(unsigned)ee[4 * q], (unsigned)ee[4 * q + 1], (unsigned)ee[4 * q + 2], (unsigned)ee[4 * q + 3]};
            *(GAS f32x4*)(gt + q * 4) = (f32x4){ev[4 * q] * inv, ev[4 * q + 1] * inv, ev[4 * q + 2] * inv, ev[4 * q + 3] * inv}; }
    }
}
constexpr int SSM_L = 64, SSM_NCH = SEQ / SSM_L;
constexpr int SSM_KERN_G = 65 * 256;
constexpr int SSM_UROW = SSM_L * 32 + 16;
constexpr int SSM_LDS_U = 0, SSM_LDS_K = SSM_NCH * SSM_UROW, SSM_LDS_S = SSM_LDS_K + 65 * 512, SSM_LDS_H = SSM_LDS_S + 128 * 33 * 4, SSM_LDS_END = SSM_LDS_H + SSM_NCH * 272;
static_assert(SSM_LDS_END <= RING_BYTES, "ssm lds");
__device__ __forceinline__ void cpow_n(float lre, float lim, double dt, int n, float& re, float& im) {
    const double ph = (double)lim * dt * (double)n * 0.15915494309189533577; const float r = (float)(ph - rint(ph));
    const float mag = __builtin_amdgcn_exp2f((float)((double)lre * dt * (double)n) * 1.44269504088896f); re = mag * __builtin_amdgcn_cosf(r); im = mag * __builtin_amdgcn_sinf(r);
}
__device__ __forceinline__ void ssm_tables(Frame& F, const Args& A) {
    const int gw = F.vcu * NWAVES + F.wave, NGW = F.G * NWAVES, lane = F.lane;
    bf16* Wt = (bf16*)(F.ws + WS_SW); bf16* Vt = (bf16*)(F.ws + WS_SVM); bf16* Kt = (bf16*)(F.ws + WS_SKERN);
    __syncthreads();
    for (int it = gw; it < 10240 + SG * 13; it += NGW) {
        if (it < 2048) {
            const int g = it >> 4, q = it & 15, mt = q >> 2, kh = (q >> 1) & 1, sh = q & 1; const int r = lane & 31, hk = lane >> 5, p = (mt * 32 + r) & 63; const bool isim = mt >= 2;
            const float lre = A.in[I_LRE][g * 64 + p], lim = A.in[I_LIM][g * 64 + p]; const double dt = (double)expf(A.in[I_LDT][g]);
            float are, aim; cpow_n(lre, lim, dt, 1, are, aim);
            const float den = lre * lre + lim * lim, nr = are - 1.0f, ni = aim; const float cre = (nr * lre + ni * lim) / den, cim = (ni * lre - nr * lim) / den;
            const GAS f32x4* bq = (const GAS f32x4*)(A.in[I_BRE] + (size_t)(g * 64 + p) * 16 + hk * 8); const GAS f32x4* bqi = (const GAS f32x4*)(A.in[I_BIM] + (size_t)(g * 64 + p) * 16 + hk * 8);
            const f32x4 br0 = bq[0], br1 = bq[1], bi0 = bqi[0], bi1 = bqi[1];
            float bbr[8], bbi[8];
#pragma unroll
            for (int j = 0; j < 8; ++j) { const float br = j < 4 ? br0[j & 3] : br1[j & 3], bi = j < 4 ? bi0[j & 3] : bi1[j & 3]; bbr[j] = cre * br - cim * bi; bbi[j] = cre * bi + cim * br; }
            float pr, pi; cpow_n(lre, lim, dt, 63 - (kh * 32 + sh * 16 + 15), pr, pi);
            bf16* Wg = Wt + (size_t)g * 128 * 1024 + ((size_t)((mt * 2 + kh) * 32) * 64 + lane) * 8;
#pragma unroll 4
            for (int sd = 15; sd >= 0; --sd) { const int s = sh * 16 + sd; unsigned w[4];
#pragma unroll
                for (int j2 = 0; j2 < 4; ++j2) { float v[2];
#pragma unroll
                    for (int e = 0; e < 2; ++e) { const int j = 2 * j2 + e; v[e] = isim ? (pr * bbi[j] + pi * bbr[j]) : (pr * bbr[j] - pi * bbi[j]); }
                    w[j2] = pk2(v[0], v[1]); }
                *(GAS v4u*)(Wg + (size_t)s * 512) = (v4u){w[0], w[1], w[2], w[3]};
                const float npr = pr * are - pi * aim, npi = pr * aim + pi * are; pr = npr; pi = npi; }
        } else if (it < 10240) {
            const int g = (it - 2048) >> 6, t = (it - 2048) & 63, p = lane; const float lre = A.in[I_LRE][g * 64 + p], lim = A.in[I_LIM][g * 64 + p]; const double dt = (double)expf(A.in[I_LDT][g]);
            float pr, pi; cpow_n(lre, lim, dt, t + 1, pr, pi);
            float cr[16], ci[16];
#pragma unroll
            for (int c = 0; c < 16; ++c) { cr[c] = A.in[I_CRE][(g * 16 + c) * 64 + p]; ci[c] = A.in[I_CIM][(g * 16 + c) * 64 + p]; }
#pragma unroll
            for (int c = 0; c < 16; ++c) { bf16* row = Vt + ((size_t)g * 1024 + t * 16 + c) * 128;
                row[p] = (bf16)f2bf(cr[c] * pr - ci[c] * pi); row[64 + p] = (bf16)f2bf(-(cr[c] * pi + ci[c] * pr)); }
        } else {
            const int r = it - 10240, g = r / 13, tb = r % 13; const int c = lane >> 2, cq = (lane & 3) * 4;
            float acc[5][4];
#pragma unroll
            for (int j = 0; j < 5; ++j)
#pragma unroll
                for (int e = 0; e < 4; ++e) acc[j][e] = 0.f;
            {
                LAS float* Lw = (LAS float*)(F.lds + RING_OFF) + F.wave * 4096;
                LAS float* Cre = Lw; LAS float* Cim = Lw + 1024; LAS float* Bre = Lw + 2048; LAS float* Bim = Lw + 3072;
                {
                    const GAS f32x4* s0 = (const GAS f32x4*)(A.in[I_CRE] + (size_t)g * 1024), * s1 = (const GAS f32x4*)(A.in[I_CIM] + (size_t)g * 1024);
                    const GAS f32x4* s2 = (const GAS f32x4*)(A.in[I_BRE] + (size_t)g * 1024), * s3 = (const GAS f32x4*)(A.in[I_BIM] + (size_t)g * 1024);
                    f32x4 t0[4], t1[4], t2[4], t3[4];
#pragma unroll
                    for (int i = 0; i < 4; ++i) { t0[i] = s0[i * 64 + lane]; t1[i] = s1[i * 64 + lane]; t2[i] = s2[i * 64 + lane]; t3[i] = s3[i * 64 + lane]; }
#pragma unroll
                    for (int i = 0; i < 4; ++i) { const int e = 4 * (i * 64 + lane), cc = e >> 6, pp = e & 63;
#pragma unroll
                        for (int k = 0; k < 4; ++k) { Cre[cc * 64 + ((pp + k + cc) & 63)] = t0[i][k]; Cim[cc * 64 + ((pp + k + cc) & 63)] = t1[i][k]; }
                        *(LAS f32x4*)(Bre + e) = t2[i]; *(LAS f32x4*)(Bim + e) = t3[i]; }
                }
                const float lre = A.in[I_LRE][g * 64 + lane], lim = A.in[I_LIM][g * 64 + lane]; const double dt = (double)expf(A.in[I_LDT][g]);
                float are, aim; cpow_n(lre, lim, dt, 1, are, aim);
                const float den = lre * lre + lim * lim, nr = are - 1.0f, ni = aim; const float cre = (nr * lre + ni * lim) / den, cim = (ni * lre - nr * lim) / den;
                float mr[5], mi[5];
                if (tb == 0) { mr[0] = 0.f; mi[0] = 0.f; mr[1] = cre; mi[1] = cim; }
                else { float pr, pi; cpow_n(lre, lim, dt, 5 * tb - 1, pr, pi); mr[0] = pr * cre - pi * cim; mi[0] = pr * cim + pi * cre; mr[1] = mr[0] * are - mi[0] * aim; mi[1] = mr[0] * aim + mi[0] * are; }
#pragma unroll
                for (int j = 2; j < 5; ++j) { mr[j] = mr[j - 1] * are - mi[j - 1] * aim; mi[j] = mr[j - 1] * aim + mi[j - 1] * are; }
                asm volatile("s_waitcnt lgkmcnt(0)" ::: "memory");
#pragma unroll 4
                for (int p = 0; p < 64; ++p) {
                    const float cr = Cre[c * 64 + ((p + c) & 63)], ci = Cim[c * 64 + ((p + c) & 63)];
                    const f32x4 br = *(const LAS f32x4*)(Bre + p * 16 + cq), bi = *(const LAS f32x4*)(Bim + p * 16 + cq);
#pragma unroll
                    for (int j = 0; j < 5; ++j) {
                        const float qr = __int_as_float(__builtin_amdgcn_readlane(__float_as_int(mr[j]), p)), qi = __int_as_float(__builtin_amdgcn_readlane(__float_as_int(mi[j]), p));
                        const float zr = cr * qr - ci * qi, zi = cr * qi + ci * qr;
#pragma unroll
                        for (int e = 0; e < 4; ++e) acc[j][e] += zr * br[e] - zi * bi[e];
                    }
                }
                asm volatile("s_waitcnt lgkmcnt(0)" ::: "memory");
            }
#pragma unroll
            for (int j = 0; j < 5; ++j) *(GAS v2u*)(Kt + (size_t)g * SSM_KERN_G + (5 * tb + j) * 256 + c * 16 + cq) = (v2u){pk2(acc[j][0], acc[j][1]), pk2(acc[j][2], acc[j][3])};
        }
    }
}
__device__ __forceinline__ float gelu_poly(float v) {
    const float av = fabsf(v), t = __builtin_amdgcn_rcpf(av * 0.2316418882f + 1.0f);
    float q = t * 0.5307027145f + (-0.7265760135f); q = q * t + 0.7107068705f; q = q * t + (-0.142248368f); q = q * t + 0.127414796f; q = q * t;
    const float e = __builtin_amdgcn_exp2f((v * v) * (-0.72134752044f));
    const float m = v * (q * e);
    return v < 0.f ? m : v - m;
}
typedef short ss_bf16x8 __attribute__((ext_vector_type(8)));
typedef float ss_f32x16 __attribute__((ext_vector_type(16)));
__device__ __forceinline__ void ssm_mfma_item(Frame& F, const Args& A, int item) {
    const int b = item >> 7, g = item & 127; int tid = F.tid; asm volatile("" : "+v"(tid));
    const int lane = tid & 63, wave = F.wave, r = lane & 31, hk = lane >> 5;
    LAS unsigned char* L = F.lds + RING_OFF;
    LAS unsigned char* UL = L + SSM_LDS_U; LAS unsigned char* KL = L + SSM_LDS_K; LAS float* SL = (LAS float*)(L + SSM_LDS_S); LAS unsigned char* HL = L + SSM_LDS_H;
    const bf16* ub = (const bf16*)(F.ws + WS_U); bf16* yg = (bf16*)(F.ws + WS_YG);
    const bf16* Wt = (const bf16*)(F.ws + WS_SW) + (size_t)g * 128 * 1024; const bf16* Vt = (const bf16*)(F.ws + WS_SVM) + (size_t)g * 1024 * 128; const bf16* Kt = (const bf16*)(F.ws + WS_SKERN) + (size_t)g * SSM_KERN_G;
    __syncthreads();
    float alr, ali;
    {
        v4u tu[8], tk[5];
#pragma unroll
        for (int q = 0; q < 8; ++q) { const int i = tid + q * 512, t = i >> 1, hf = i & 1; tu[q] = *(const GAS v4u*)(ub + ((size_t)(b * 128 + g) * SEQ) * 16 + (size_t)i * 8); }
#pragma unroll
        for (int q = 0; q < 5; ++q) { const int i = tid + q * 512; tk[q] = (i < 65 * 32) ? *(const GAS v4u*)(Kt + i * 8) : (v4u){0u, 0u, 0u, 0u}; }
        { const int p = tid & 63; const float lre = A.in[I_LRE][g * 64 + p], lim = A.in[I_LIM][g * 64 + p]; const double dt = (double)expf(A.in[I_LDT][g]); cpow_n(lre, lim, dt, 64, alr, ali); }
#pragma unroll
        for (int q = 0; q < 8; ++q) { const int i = tid + q * 512, t = i >> 1, hf = i & 1; *(LAS v4u*)(UL + (t >> 6) * SSM_UROW + (t & 63) * 32 + hf * 16) = tu[q]; }
#pragma unroll
        for (int q = 0; q < 5; ++q) { const int i = tid + q * 512; if (i < 65 * 32) *(LAS v4u*)(KL + i * 16) = tk[q]; }
    }
    __syncthreads();
    {
        ss_f32x16 acc = {};
        const int mt = wave & 3, kh = wave >> 2;
        const bf16* ap = Wt + ((size_t)((mt * 2 + kh) * 32) * 64 + lane) * 8;
        const LAS unsigned char* bp = UL + r * SSM_UROW + hk * 16 + kh * 1024;
#pragma unroll 16
        for (int s = 0; s < 32; ++s) { const ss_bf16x8 a = *(const GAS ss_bf16x8*)(ap + s * 512); const ss_bf16x8 bb = *(const LAS ss_bf16x8*)(bp + s * 32);
            acc = __builtin_amdgcn_mfma_f32_32x32x16_bf16(a, bb, acc, 0, 0, 0); }
        if (kh == 0) {
#pragma unroll
            for (int rg = 0; rg < 16; ++rg) { const int row = mt * 32 + (rg & 3) + 8 * (rg >> 2) + 4 * hk; SL[row * 33 + r] = acc[rg]; } }
        __syncthreads();
        if (kh == 1) {
#pragma unroll
            for (int rg = 0; rg < 16; ++rg) { const int row = mt * 32 + (rg & 3) + 8 * (rg >> 2) + 4 * hk; SL[row * 33 + r] += acc[rg]; } }
    }
    __syncthreads();
    if (tid < 64) {
        const int p = tid;
        float sr[32], si[32];
#pragma unroll
        for (int n = 0; n < SSM_NCH; ++n) { sr[n] = SL[p * 33 + n]; si[n] = SL[(64 + p) * 33 + n]; }
        float hre = 0.f, him = 0.f;
#pragma unroll
        for (int n = 0; n < SSM_NCH; ++n) {
            *(LAS unsigned short*)(HL + n * 272 + p * 2) = (unsigned short)f2bf(hre); *(LAS unsigned short*)(HL + n * 272 + 128 + p * 2) = (unsigned short)f2bf(him);
            const float nre = alr * hre - ali * him + sr[n], nim = alr * him + ali * hre + si[n]; hre = nre; him = nim;
        }
    }
    __syncthreads();
    {
        ss_f32x16 acc[4] = {};
        int ti[4] = {wave, 15 - wave, 16 + wave, 31 - wave};
        int lane = tid & 63; asm volatile("" : "+v"(lane));
        const int r = lane & 31, hk = lane >> 5;
        const LAS unsigned char* bp = UL + r * SSM_UROW + hk * 16;
        const LAS unsigned char* kp = KL + ((lane >> 4) & 1) * 512 + (lane & 15) * 32 + hk * 16;
        const LAS unsigned char* hp = HL + r * 272 + hk * 16;
#pragma unroll
        for (int pr2 = 0; pr2 < 2; ++pr2) {
            ss_bf16x8 va[2][8];
#pragma unroll
            for (int qq = 0; qq < 2; ++qq)
#pragma unroll
                for (int ks = 0; ks < 8; ++ks) va[qq][ks] = *(const GAS ss_bf16x8*)(Vt + (size_t)(ti[2 * pr2 + qq] * 32 + r) * 128 + ks * 16 + hk * 8);
#pragma unroll
            for (int qq = 0; qq < 2; ++qq) { const int q = 2 * pr2 + qq; const int ns = 2 * ti[q] + 2; const LAS unsigned char* ka = kp + (2 * ti[q] + 1) * 512;
#pragma unroll 4
                for (int s = 0; s < ns; ++s) { const ss_bf16x8 bb = *(const LAS ss_bf16x8*)(bp + s * 32); const ss_bf16x8 a = *(const LAS ss_bf16x8*)(ka - s * 512);
                    acc[q] = __builtin_amdgcn_mfma_f32_32x32x16_bf16(a, bb, acc[q], 0, 0, 0); } }
#pragma unroll
            for (int ks = 0; ks < 8; ++ks) { const ss_bf16x8 hb = *(const LAS ss_bf16x8*)(hp + ks * 32);
#pragma unroll
                for (int qq = 0; qq < 2; ++qq) acc[2 * pr2 + qq] = __builtin_amdgcn_mfma_f32_32x32x16_bf16(va[qq][ks], hb, acc[2 * pr2 + qq], 0, 0, 0); }
        }
        __syncthreads();
#pragma unroll
        for (int q = 0; q < 4; ++q)
#pragma unroll
            for (int rg = 0; rg < 16; ++rg) { const int row = (rg & 3) + 8 * (rg >> 2) + 4 * hk; const int t = 2 * ti[q] + (row >> 4), c = row & 15;
                LAS unsigned short* up = (LAS unsigned short*)(UL + r * SSM_UROW + t * 32 + c * 2);
                const float y = acc[q][rg] + A.in[I_SD][g * 16 + c] * bf2f(*up);
                *up = (unsigned short)f2bf(gelu_poly(y)); }
    }
    __syncthreads();
    for (int i = tid; i < 4096; i += 512) { const int t = i >> 1, hf = i & 1; const v4u w = *(const LAS v4u*)(UL + (t >> 6) * SSM_UROW + (t & 63) * 32 + hf * 16);
        *(GAS v4u*)(yg + (size_t)(b * SEQ + t) * SW + g * 16 + hf * 8) = w; }
}
constexpr size_t SLAB_BYTES = (size_t)PE * 128;
constexpr int NSLAB = DM / 128;
constexpr int NSLABU = DM / 256;
typedef __amdgpu_buffer_rsrc_t rsrc_t;
__device__ __forceinline__ rsrc_t mk_rsrc(const void* p, unsigned bytes) { return __builtin_amdgcn_make_buffer_rsrc((void*)p, (short)0, (int)bytes, 0x00020000); }
#ifndef GATHER_AUX
#define GATHER_AUX 0
#endif
__device__ __forceinline__ v4u bld(rsrc_t r, unsigned voff, unsigned soff) { return __builtin_amdgcn_raw_buffer_load_b128(r, (int)voff, (int)soff, GATHER_AUX); }
__device__ __forceinline__ float dpp_f(float v, const int ctrl) { return v; }
#define DPP_ADD(v, ctrl) (v) += __int_as_float(__builtin_amdgcn_mov_dpp(__float_as_int(v), (ctrl), 0xF, 0xF, true))
__device__ __forceinline__ unsigned nib4(float v) { const int q = (int)rintf(fminf(fmaxf(v, -7.f), 7.f)); return (unsigned)q & 15u; }
__device__ __forceinline__ unsigned pack_i8(float a, float b, float c, float d) {
    const int ia = (int)rintf(a), ib = (int)rintf(b), ic = (int)rintf(c), id = (int)rintf(d);
    return ((unsigned)ia & 0xffu) | (((unsigned)ib & 0xffu) << 8) | (((unsigned)ic & 0xffu) << 16) | ((unsigned)id << 24);
}
__device__ __forceinline__ void ptab_load(f32x4 (&v)[16], const float* src, int lane) {
    const GAS f32x4* p = (const GAS f32x4*)src + lane;
#pragma unroll
    for (int k = 0; k < 16; ++k) v[k] = p[64 * k];
}
__device__ __forceinline__ void ptab_quant(const f32x4 (&vin)[16], bool isv, const LAS f32x4* gf, LAS unsigned* ob, LAS float* sb, int lane) {
    f32x4 v[16]; float amax = 0.f;
#pragma unroll
    for (int k = 0; k < 16; ++k) { f32x4 t = vin[k]; if (!isv) t = t * gf[64 * k];
        v[k] = t; amax = fmaxf(amax, fmaxf(fmaxf(fabsf(t.x), fabsf(t.y)), fmaxf(fabsf(t.z), fabsf(t.w)))); }
    amax = wave_max(amax);
    const float qmax = isv ? 6.0f : 7.0f;
    const float scale = amax > 0.f ? amax / qmax : 1.0f, inv = 1.0f / scale;
#pragma unroll
    for (int k = 0; k < 16; ++k) { const f32x4 t = v[k] * inv; unsigned hw;
        if (isv) { unsigned d = 0u; d = __builtin_amdgcn_cvt_scalef32_pk_fp4_f32(d, fminf(fmaxf(t.x, -6.f), 6.f), fminf(fmaxf(t.y, -6.f), 6.f), 1.0f, 0);
            d = __builtin_amdgcn_cvt_scalef32_pk_fp4_f32(d, fminf(fmaxf(t.z, -6.f), 6.f), fminf(fmaxf(t.w, -6.f), 6.f), 1.0f, 1); hw = d & 0xffffu; }
        else hw = nib4(t.x) | (nib4(t.y) << 4) | (nib4(t.z) << 8) | (nib4(t.w) << 12);
        const unsigned other = (unsigned)__builtin_amdgcn_mov_dpp((int)hw, 0xB1, 0xF, 0xF, true);
        if ((lane & 1) == 0) ob[k * 32 + (lane >> 1)] = hw | (other << 16); }
    if (lane == 0) sb[0] = scale;
}
__device__ __forceinline__ void peer_tables_slab(Frame& F, const Args& A) {
    const int gw = F.vcu * NWAVES + F.wave, NGW = F.G * NWAVES, lane = F.lane;
    unsigned char* U8 = F.ws + WS_U8; unsigned char* V8 = F.ws + WS_V8; float* SU = (float*)(F.ws + WS_SU); float* SV = (float*)(F.ws + WS_SV);
    LAS unsigned* OB = (LAS unsigned*)(F.lds + RING_OFF) + F.wave * 2304;
    LAS float* SB = (LAS float*)(OB + 2048);
    __syncthreads();
    LAS f32x4* GL = (LAS f32x4*)(F.lds + RING_OFF + 81920);
    for (int i = F.tid; i < DM / 4; i += NWAVES * 64) GL[i] = ((const GAS f32x4*)A.in[I_GFFN])[i];
    __syncthreads();
    const LAS f32x4* gf = GL + lane;
    if (gw >= 2 * PE) return;
    const int ntot = (2 * PE - gw + NGW - 1) / NGW;
#define ROWID(k) (gw + ((k) < ntot ? (k) : ntot - 1) * NGW)
#define ROWSRC(rr) (((rr) >= PE ? A.in[I_PV] : A.in[I_PU]) + (size_t)((rr) >= PE ? (rr) - PE : (rr)) * DM)
    f32x4 va[16], vb[16];
    ptab_load(va, ROWSRC(ROWID(0)), lane);
    for (int kb = 0; kb < ntot; kb += 4) {
        ptab_load(vb, ROWSRC(ROWID(kb + 1)), lane); ptab_quant(va, ROWID(kb) >= PE, gf, OB, SB, lane);
        ptab_load(va, ROWSRC(ROWID(kb + 2)), lane); ptab_quant(vb, ROWID(kb + 1) >= PE, gf, OB + 512, SB + 1, lane);
        ptab_load(vb, ROWSRC(ROWID(kb + 3)), lane); ptab_quant(va, ROWID(kb + 2) >= PE, gf, OB + 1024, SB + 2, lane);
        ptab_load(va, ROWSRC(ROWID(kb + 4)), lane); ptab_quant(vb, ROWID(kb + 3) >= PE, gf, OB + 1536, SB + 3, lane);
        asm volatile("s_waitcnt lgkmcnt(0)" ::: "memory");
#pragma unroll
        for (int i = 0; i < 4; ++i) { if (kb + i < ntot) { const int rr = ROWID(kb + i); const bool isv = rr >= PE; const int e = isv ? rr - PE : rr;
                unsigned char* dst = (isv ? V8 : U8) + (size_t)e * 128;
#pragma unroll
                for (int q = 0; q < 2; ++q) { const int d4 = q * 64 + lane; *(GAS v4u*)(dst + (size_t)(d4 >> 3) * SLAB_BYTES + (d4 & 7) * 16) = *(const LAS v4u*)(OB + i * 512 + d4 * 4); }
                if (lane == 0) { if (isv) SV[e] = SB[i]; else SU[e] = SB[i]; } } }
        asm volatile("s_waitcnt lgkmcnt(0)" ::: "memory");
    }
#undef ROWID
#undef ROWSRC
}
__device__ __forceinline__ void peer_xq_phase(Frame& F) {
    const int gw = F.vcu * NWAVES + F.wave, NGW = F.G * NWAVES, lane = F.lane;
    const bf16* x1 = (const bf16*)(F.ws + WS_X1BF); unsigned* XH = (unsigned*)(F.ws + WS_XH); unsigned* XL = (unsigned*)(F.ws + WS_XL); float* XS = (float*)(F.ws + WS_XS);
    v4u nx[8];
    if (gw < T) { const GAS v4u* s0 = (const GAS v4u*)(x1 + (size_t)gw * DM) + lane;
#pragma unroll
        for (int k = 0; k < 8; ++k) nx[k] = s0[64 * k]; }
    for (int tok = gw; tok < T; tok += NGW) {
        v4u v[8]; float amax = 0.f;
#pragma unroll
        for (int k = 0; k < 8; ++k) { const v4u t = nx[k]; v[k] = t;
#pragma unroll
            for (int e = 0; e < 4; ++e) amax = fmaxf(amax, fmaxf(fabsf(bflo(t[e])), fabsf(bfhi(t[e])))); }
        { const int tn = tok + NGW < T ? tok + NGW : tok; const GAS v4u* sn = (const GAS v4u*)(x1 + (size_t)tn * DM) + lane;
#pragma unroll
          for (int k = 0; k < 8; ++k) nx[k] = sn[64 * k]; }
        amax = wave_max(amax);
        const float qs = amax > 0.f ? 119.0f / amax : 0.f;
#pragma unroll
        for (int k = 0; k < 8; ++k) { unsigned hh = 0u, ll = 0u;
#pragma unroll
            for (int e = 0; e < 8; ++e) { const float xv = (e & 1) ? bfhi(v[k][e >> 1]) : bflo(v[k][e >> 1]); const int q = (int)rintf(xv * qs); const int l = ((q & 15) ^ 8) - 8; const int h = (q - l) >> 4;
                ll |= ((unsigned)l & 15u) << (4 * e); hh |= ((unsigned)h & 15u) << (4 * e); }
            XH[(size_t)tok * 512 + 64 * k + lane] = hh; XL[(size_t)tok * 512 + 64 * k + lane] = ll; }
        if (lane == 0) XS[tok] = amax * (1.0f / 119.0f);
    }
}
#define DPPI(v, ctrl) __builtin_amdgcn_mov_dpp((v), (ctrl), 0xF, 0xF, true)
__device__ __forceinline__ void pu_issue(v4u (&rows)[16], v4u& xh, v4u& xl, const v4u (&ids)[4], rsrc_t rT, unsigned j16, const unsigned* xhp, const unsigned* xlp) {
#pragma unroll
    for (int i = 0; i < 16; ++i) rows[i] = bld(rT, ids[i >> 2][i & 3] * 128u + j16, 0);
    xh = *(const GAS v4u*)xhp; xl = *(const GAS v4u*)xlp;
}
__device__ __forceinline__ void pu_compute(const v4u (&rows)[16], const v4u xh, const v4u xl, float deq, int j, LAS float* dstbase, bool accum) {
    int v[16];
#pragma unroll
    for (int i = 0; i < 16; ++i) { int ah = 0, al = 0;
#pragma unroll
        for (int q = 0; q < 4; ++q) { ah = __builtin_amdgcn_sdot8((int)rows[i][q], (int)xh[q], ah, false); al = __builtin_amdgcn_sdot8((int)rows[i][q], (int)xl[q], al, false); }
        v[i] = (ah << 4) + al; }
    const bool L2 = (j & 4) != 0, L0 = (j & 1) != 0, L1 = (j & 2) != 0;
    int w[8], u[4], z[2];
#pragma unroll
    for (int r = 0; r < 8; ++r) { const int keep = L2 ? v[r + 8] : v[r], send = L2 ? v[r] : v[r + 8]; w[r] = keep + DPPI(send, 0x141); }
#pragma unroll
    for (int r = 0; r < 4; ++r) { const int keep = L0 ? w[r + 4] : w[r], send = L0 ? w[r] : w[r + 4]; u[r] = keep + DPPI(send, 0xB1); }
#pragma unroll
    for (int r = 0; r < 2; ++r) { const int keep = L1 ? u[r + 2] : u[r], send = L1 ? u[r] : u[r + 2]; z[r] = keep + DPPI(send, 0x4E); }
    const int rbase = 8 * (j >> 2) + 4 * (j & 1) + 2 * ((j >> 1) & 1);
    f32x2 res = {(float)z[0] * deq, (float)z[1] * deq};
    if (accum) res += *(const LAS f32x2*)(dstbase + rbase);
    *(LAS f32x2*)(dstbase + rbase) = res;
}
__device__ __forceinline__ void pu_ids(v4u (&ids)[4], const int* ep) {
    const GAS v4u* ip = (const GAS v4u*)ep; ids[0] = ip[0]; ids[1] = ip[1]; ids[2] = ip[2]; ids[3] = ip[3];
}
__device__ __forceinline__ void peer_u_phase(Frame& F) {
    const int nx = F.G / 8, xcd = F.vcu / nx, c = F.vcu % nx, gwl = c * NWAVES + F.wave, nwl = nx * NWAVES, lane = F.lane, j = lane & 7, grp = lane >> 3;
    const int* ex = (const int*)(F.ws + WS_EXP) + grp * 16; float* part = (float*)(F.ws + WS_PART);
    const unsigned* XH = (const unsigned*)(F.ws + WS_XH) + j * 4; const unsigned* XL = (const unsigned*)(F.ws + WS_XL) + j * 4; const float* XS = (const float*)(F.ws + WS_XS);
    LAS float* PL = (LAS float*)(F.lds + RING_OFF) + F.wave * 4096;
    const unsigned j16 = (unsigned)j * 16u;
    if (gwl >= T) return;
    const int ntot = (T - gwl + nwl - 1) / nwl;
    for (int kb = 0; kb < ntot; kb += 32) {
        const int n = (ntot - kb) < 32 ? (ntot - kb) : 32;
#define TOK(k) (gwl + (kb + ((k) < n ? (k) : n - 1)) * nwl)
        for (int si = 0; si < NSLABU / 8; ++si) {
            const int slab = xcd * (NSLABU / 8) + si; const bool accum = si > 0;
            const rsrc_t rT = mk_rsrc(F.ws + WS_U8 + (size_t)slab * SLAB_BYTES, (unsigned)SLAB_BYTES);
            v4u id0[4], id1[4], rowA[16], rowB[16], hA, lA, hB, lB;
            pu_ids(id0, ex + (size_t)TOK(0) * PSEL); pu_ids(id1, ex + (size_t)TOK(1) * PSEL);
            pu_issue(rowA, hA, lA, id0, rT, j16, XH + (size_t)TOK(0) * 512 + slab * 32, XL + (size_t)TOK(0) * 512 + slab * 32);
            for (int k = 0; k < n; k += 2) {
                pu_ids(id0, ex + (size_t)TOK(k + 2) * PSEL);
                pu_issue(rowB, hB, lB, id1, rT, j16, XH + (size_t)TOK(k + 1) * 512 + slab * 32, XL + (size_t)TOK(k + 1) * 512 + slab * 32);
                pu_compute(rowA, hA, lA, XS[TOK(k)], j, PL + k * 128 + grp * 16, accum);
                pu_ids(id1, ex + (size_t)TOK(k + 3) * PSEL);
                pu_issue(rowA, hA, lA, id0, rT, j16, XH + (size_t)TOK(k + 2) * 512 + slab * 32, XL + (size_t)TOK(k + 2) * 512 + slab * 32);
                pu_compute(rowB, hB, lB, XS[TOK(k + 1)], j, PL + (k + 1) * 128 + grp * 16, accum);
            }
        }
        asm volatile("s_waitcnt lgkmcnt(0)" ::: "memory");
        for (int k = 0; k < n; ++k) { const f32x2 v = *(const LAS f32x2*)(PL + k * 128 + lane * 2); *(GAS f32x2*)(part + ((size_t)xcd * T + TOK(k)) * PSEL + lane * 2) = v; }
        asm volatile("s_waitcnt lgkmcnt(0)" ::: "memory");
#undef TOK
    }
}
__device__ __forceinline__ void pc_emit(unsigned char* cb, float x, int s) {
    const unsigned h = (unsigned)__builtin_amdgcn_cvt_pk_fp8_f32(x, 0.f, 0, false) & 0xffu;
    const int hh = (s >> 5) & 1, i = s & 15, q = 2 * (s >> 6) + ((s >> 4) & 1);
    cb[(hh * 16 + i) * 4 + q] = (unsigned char)h;
}
__device__ __forceinline__ void peer_combine_phase(Frame& F) {
    const int gw = F.vcu * NWAVES + F.wave, NGW = F.G * NWAVES, lane = F.lane;
    const int* ex = (const int*)(F.ws + WS_EXP); const float* gt = (const float*)(F.ws + WS_GATE); const float* part = (const float*)(F.ws + WS_PART);
    const float* SU = (const float*)(F.ws + WS_SU); const float* SV = (const float*)(F.ws + WS_SV);
    unsigned char* CB = F.ws + WS_CB; float* TS = (float*)(F.ws + WS_TS);
    for (int tok0 = gw; tok0 < T; tok0 += 4 * NGW) {
        float s0[4], s1[4], g0[4], g1[4], r1[4]; int e0[4], e1[4];
#pragma unroll
        for (int q = 0; q < 4; ++q) { const int tok = (tok0 + q * NGW) < T ? tok0 + q * NGW : tok0;
            r1[q] = ((const float*)(F.ctl + CW_SSQ1))[tok]; s0[q] = 0.f; s1[q] = 0.f;
#pragma unroll
            for (int s = 0; s < 8; ++s) { const float* pp = part + ((size_t)s * T + tok) * PSEL; s0[q] += pp[lane]; s1[q] += pp[64 + lane]; }
            e0[q] = ex[(size_t)tok * PSEL + lane]; e1[q] = ex[(size_t)tok * PSEL + 64 + lane];
            g0[q] = gt[(size_t)tok * PSEL + lane]; g1[q] = gt[(size_t)tok * PSEL + 64 + lane]; }
        float su0[4], su1[4], sv0[4], sv1[4];
#pragma unroll
        for (int q = 0; q < 4; ++q) { su0[q] = SU[e0[q]]; su1[q] = SU[e1[q]]; sv0[q] = SV[e0[q]]; sv1[q] = SV[e1[q]]; }
#pragma unroll
        for (int q = 0; q < 4; ++q) { const int tok = tok0 + q * NGW; if (tok < T) {
            const float rr = 1.0f / sqrtf(r1[q] * (1.0f / DM) + RMS_EPS);
            const float c0 = g0[q] * gelu_erf(s0[q] * su0[q] * rr) * sv0[q], c1 = g1[q] * gelu_erf(s1[q] * su1[q] * rr) * sv1[q];
            const float cmax = wave_max(fmaxf(fabsf(c0), fabsf(c1)));
            const float sc = cmax > 0.f ? 224.0f / cmax : 0.f;
            if (lane == 0) TS[tok] = cmax * (1.0f / 224.0f);
            pc_emit(CB + (size_t)tok * 128, c0 * sc, lane); pc_emit(CB + (size_t)tok * 128, c1 * sc, 64 + lane); } }
    }
}
typedef int v8i __attribute__((ext_vector_type(8)));
typedef int v4i_ __attribute__((ext_vector_type(4)));
__device__ __forceinline__ void pv_ids(v4u (&ids)[4], const int* ep) {
    const GAS v4u* ip = (const GAS v4u*)ep; ids[0] = ip[0]; ids[1] = ip[1]; ids[2] = ip[2]; ids[3] = ip[3];
}
__device__ __forceinline__ void pv_issue(v4u (&rows)[16], v4u (&w)[4], float& ts, const v4u (&ids)[4], rsrc_t rT, unsigned j16, const unsigned* cbp, const float* tsp) {
#pragma unroll
    for (int i = 0; i < 16; ++i) rows[i] = bld(rT, ids[i >> 2][i & 3] * 128u + j16, 0);
    const GAS v4u* cq = (const GAS v4u*)cbp; w[0] = cq[0]; w[1] = cq[1]; w[2] = cq[2]; w[3] = cq[3]; ts = *tsp;
}
__device__ __forceinline__ void pv_compute(const v4u (&rows)[16], const v4u (&w)[4], float ts, const unsigned (&sel)[8], LAS v2u* ol) {
    f32x4 d0 = {0.f, 0.f, 0.f, 0.f}, d1 = {0.f, 0.f, 0.f, 0.f};
#pragma unroll
    for (int i = 0; i < 16; ++i) {
        const auto s02 = __builtin_amdgcn_permlane16_swap(rows[i][0], rows[i][2], false, false); const auto s13 = __builtin_amdgcn_permlane16_swap(rows[i][1], rows[i][3], false, false);
        const unsigned t0 = s02[0], t2 = s02[1], t1 = s13[0], t3 = s13[1];
        v8i b = {0, 0, 0, 0, 0, 0, 0, 0};
        b[0] = __builtin_amdgcn_update_dpp((int)t0, (int)t1, 0x128, 0xF, 0xC, false); b[1] = __builtin_amdgcn_update_dpp((int)t1, (int)t0, 0x128, 0xF, 0x3, false);
        b[2] = __builtin_amdgcn_update_dpp((int)t2, (int)t3, 0x128, 0xF, 0xC, false); b[3] = __builtin_amdgcn_update_dpp((int)t3, (int)t2, 0x128, 0xF, 0x3, false);
        const unsigned W = w[i >> 2][i & 3];
        v8i a;
#pragma unroll
        for (int q = 0; q < 8; ++q) a[q] = (int)__builtin_amdgcn_perm(W, W, sel[q]);
        if (i & 1) d1 = __builtin_amdgcn_mfma_scale_f32_16x16x128_f8f6f4(a, b, d1, 0, 4, 0, 0x7f7f7f7f, 0, 0x7f7f7f7f);
        else d0 = __builtin_amdgcn_mfma_scale_f32_16x16x128_f8f6f4(a, b, d0, 0, 4, 0, 0x7f7f7f7f, 0, 0x7f7f7f7f);
    }
    const f32x4 o = (d0 + d1) * ts;
    *ol = (v2u){pk2(o[0], o[1]), pk2(o[2], o[3])};
}
__device__ __forceinline__ void peer_v_phase(Frame& F) {
    const int nx = F.G / 8, xcd = F.vcu / nx, c = F.vcu % nx, gwl = c * NWAVES + F.wave, nwl = nx * NWAVES, lane = F.lane, j = lane & 7, grp = lane >> 3;
    const int m = lane & 15, kq = lane >> 4;
    const int* ex = (const int*)(F.ws + WS_EXP) + grp * 16; const unsigned* cbp = (const unsigned*)(F.ws + WS_CB) + (kq & 1) * 16; const float* TS = (const float*)(F.ws + WS_TS);
    bf16* peer = (bf16*)(F.ws + WS_X2B);
    LAS unsigned char* OL = F.lds + RING_OFF + F.wave * 16384;
    const unsigned j16 = (unsigned)j * 16u;
    unsigned sel[8];
#pragma unroll
    for (int v = 0; v < 4; ++v) { const unsigned sb = (0x0c0c0c0cu & ~(0xffu << (8 * (m & 3)))) | ((unsigned)v << (8 * (m & 3))); const bool par = ((m >> 2) & 1) != 0, valid = (kq >> 1) == (m >> 3);
        sel[2 * v] = (par || !valid) ? 0x0c0c0c0cu : sb; sel[2 * v + 1] = (par && valid) ? sb : 0x0c0c0c0cu; }
    LAS v2u* olp = (LAS v2u*)(OL + (32 * (lane & 7) + 16 * (lane >> 5) + 8 * ((lane >> 3) & 1) + 4 * ((lane >> 4) & 1)) * 2);
    if (gwl >= T) return;
    const int ntot = (T - gwl + nwl - 1) / nwl;
    for (int si = 0; si < NSLABU / 8; ++si) {
        const int slab = xcd * (NSLABU / 8) + si;
        const rsrc_t rT = mk_rsrc(F.ws + WS_V8 + (size_t)slab * SLAB_BYTES, (unsigned)SLAB_BYTES);
        for (int kb = 0; kb < ntot; kb += 32) {
            const int n = (ntot - kb) < 32 ? (ntot - kb) : 32;
#define TOK(k) (gwl + (kb + ((k) < n ? (k) : n - 1)) * nwl)
            v4u id0[4], id1[4], rowA[16], rowB[16], wA[4], wB[4]; float tA, tB;
            pv_ids(id0, ex + (size_t)TOK(0) * PSEL); pv_ids(id1, ex + (size_t)TOK(1) * PSEL);
            pv_issue(rowA, wA, tA, id0, rT, j16, cbp + (size_t)TOK(0) * 32, TS + TOK(0));
            for (int k = 0; k < n; k += 2) {
                pv_ids(id0, ex + (size_t)TOK(k + 2) * PSEL);
                pv_issue(rowB, wB, tB, id1, rT, j16, cbp + (size_t)TOK(k + 1) * 32, TS + TOK(k + 1));
                __builtin_amdgcn_sched_barrier(0);
                pv_compute(rowA, wA, tA, sel, olp + k * 64);
                __builtin_amdgcn_sched_barrier(0);
                pv_ids(id1, ex + (size_t)TOK(k + 3) * PSEL);
                pv_issue(rowA, wA, tA, id0, rT, j16, cbp + (size_t)TOK(k + 2) * 32, TS + TOK(k + 2));
                __builtin_amdgcn_sched_barrier(0);
                pv_compute(rowB, wB, tB, sel, olp + (k + 1) * 64);
                __builtin_amdgcn_sched_barrier(0);
            }
            asm volatile("s_waitcnt lgkmcnt(0)" ::: "memory");
            for (int k = 0; k < n; ++k) { const v2u o = *(const LAS v2u*)(OL + k * 512 + lane * 8); *(GAS v2u*)(peer + (size_t)TOK(k) * DM + slab * 256 + lane * 4) = o; }
            asm volatile("s_waitcnt lgkmcnt(0)" ::: "memory");
#undef TOK
        }
    }
}
__device__ __forceinline__ void final_norm_phase(Frame& F, const Args& A) {
    const int gw = F.vcu * NWAVES + F.wave, NGW = F.G * NWAVES, lane = F.lane;
    const float* gfin = A.in[I_GFIN]; const bf16* x1 = (const bf16*)(F.ws + WS_X1BF); const bf16* peer = (const bf16*)(F.ws + WS_X2B);
    f32x4 ga[8], gb[8];
    { const GAS f32x4* gq = (const GAS f32x4*)gfin + 2 * lane;
#pragma unroll
      for (int k = 0; k < 8; ++k) { ga[k] = gq[128 * k]; gb[k] = gq[128 * k + 1]; } }
    v4u na[8], nb[8];
    if (gw < T) { const GAS v4u* p1 = (const GAS v4u*)(x1 + (size_t)gw * DM) + lane; const GAS v4u* p2 = (const GAS v4u*)(peer + (size_t)gw * DM) + lane;
#pragma unroll
        for (int k = 0; k < 8; ++k) { na[k] = p1[64 * k]; nb[k] = p2[64 * k]; } }
    for (int tok = gw; tok < T; tok += NGW) {
        GAS f32x4* o = (GAS f32x4*)(F.out + (size_t)tok * DM) + 2 * lane;
        f32x4 xa[8], xb[8]; float ss = 0.f;
#pragma unroll
        for (int k = 0; k < 8; ++k) { const v4u a = na[k], b = nb[k];
            xa[k] = (f32x4){bflo(a.x) + bflo(b.x), bfhi(a.x) + bfhi(b.x), bflo(a.y) + bflo(b.y), bfhi(a.y) + bfhi(b.y)};
            xb[k] = (f32x4){bflo(a.z) + bflo(b.z), bfhi(a.z) + bfhi(b.z), bflo(a.w) + bflo(b.w), bfhi(a.w) + bfhi(b.w)};
            ss += (xa[k].x * xa[k].x + xa[k].y * xa[k].y) + (xa[k].z * xa[k].z + xa[k].w * xa[k].w) + (xb[k].x * xb[k].x + xb[k].y * xb[k].y) + (xb[k].z * xb[k].z + xb[k].w * xb[k].w); }
        { const int tn = tok + NGW < T ? tok + NGW : tok; const GAS v4u* p1 = (const GAS v4u*)(x1 + (size_t)tn * DM) + lane; const GAS v4u* p2 = (const GAS v4u*)(peer + (size_t)tn * DM) + lane;
#pragma unroll
          for (int k = 0; k < 8; ++k) { na[k] = p1[64 * k]; nb[k] = p2[64 * k]; } }
        ss = wave_sum(ss);
        const float rf = 1.0f / sqrtf(ss * (1.0f / DM) + RMS_EPS);
#pragma unroll
        for (int k = 0; k < 8; ++k) { o[128 * k] = xa[k] * rf * ga[k]; o[128 * k + 1] = xb[k] * rf * gb[k]; }
    }
}
#ifndef MK_N_LAUNCHES
#define MK_N_LAUNCHES 1
#endif
constexpr int N_PHASES = 13;
__global__ void __launch_bounds__(NWAVES * 64, 2) fwd_kernel(Args args) {
    extern __shared__ __attribute__((aligned(16))) unsigned char lds[];
    Frame F;
    F.lds = (LAS unsigned char*)lds;
    F.MISC = (volatile LAS unsigned*)(F.lds + MISC_OFF);
    F.tid = threadIdx.x; F.lane = F.tid & 63; F.wave = __builtin_amdgcn_readfirstlane(F.tid >> 6);
    F.G = gridDim.x; { const int bx = blockIdx.x; F.vcu = (F.G % 8 == 0) ? (bx % 8) * (F.G / 8) + bx / 8 : bx; }
    F.ws = args.ws; F.out = args.out;
    F.ctl = (gu32*)(args.ws + WS_CTL);
    for (int u = F.tid; u < (LDS_BYTES - LDSCTL_OFF) / 4; u += NWAVES * 64) ((LAS unsigned*)(F.lds + LDSCTL_OFF))[u] = 0u;
    __syncthreads();
    const int lo = args.ph_lo, hi = args.ph_hi;
    const bool multi = (hi - lo) > 1;
    XcdBarrier bar; bar.bar = (unsigned*)(F.ctl + CW_BAR); bar.x = 0; bar.st = nullptr;
    if (multi) bar = xcd_barrier_post((unsigned*)(F.ctl + CW_BAR), F.MISC + 8);
#define IN(k) (lo <= (k) && (k) < hi)
#define BOTH(k) (IN(k) && IN((k) + 1))
#define GRID_BAR() xcd_barrier(bar)
#ifndef PROBE_GEMM
#define PROBE_GEMM 0
#endif
#ifndef PROBE_MASK
#define PROBE_MASK 0
#endif
#define REP(k) for (int rep_ = 0; rep_ < 1 + ((PROBE_MASK >> (k)) & 1); ++rep_)

    if (IN(0)) {
#ifndef P0_MASK
#define P0_MASK 0
#endif
#ifndef P0_ORDER_A
#define P0_ORDER_A 1
#endif
        for (int r0_ = 0; r0_ < 1 + (P0_MASK & 1); ++r0_) p0_prologue(F, args, P0_ORDER_A);
        for (int r0_ = 0; r0_ < 1 + ((P0_MASK >> 1) & 1); ++r0_) peer_tables_slab(F, args);
#if SSM_MFMA
        for (int r0_ = 0; r0_ < 1 + ((P0_MASK >> 2) & 1); ++r0_) ssm_tables(F, args);
#endif
        if (P0_ORDER_A != 7) { __syncthreads(); p0_prologue(F, args, 7 & ~P0_ORDER_A); }
        if (BOTH(0)) GRID_BAR(); }

    if (IN(1)) { REP(1) {
        { pg8::Gemm g{(const pg8::bf16_t*)(F.ws + WS_H), (const pg8::bf16_t*)(F.ws + WS_WIN), T, NSPLIT, DM}; pg8::StaticOrder S; S.init(T, NSPLIT, F.G, (int)blockIdx.x);
          pg8::EpiInProj E{(pg8::bf16_t*)(F.ws + WS_QKV), (pg8::bf16_t*)(F.ws + WS_U), 0, 1.0f};
          pg8::gemm_phase<pg8::EpiInProj, pg8::StaticOrder, true, true>(F.lds + RING_OFF, g, S, E);
#if PROBE_GEMM || defined(PROBE_INBF)
          pg8::gemm_phase<pg8::EpiInProj, pg8::StaticOrder, true, true>(F.lds + RING_OFF, g, S, E);
#endif
        }
        { pg8::Gemm g{(const pg8::bf16_t*)(F.ws + WS_H8), (const pg8::bf16_t*)(F.ws + WS_WIN8), T, NIN - NSPLIT, DM}; pg8::StaticOrder S; S.init(T, NIN - NSPLIT, F.G, (int)blockIdx.x);
          pg8::EpiInProj E{(pg8::bf16_t*)(F.ws + WS_QKV), (pg8::bf16_t*)(F.ws + WS_U), NSPLIT / 256, 1.0f / (pg8::FP8_SH * pg8::FP8_SWI)};
          pg8::gemm_phase<pg8::EpiInProj, pg8::StaticOrder, true, true, false, true>(F.lds + RING_OFF, g, S, E);
#if PROBE_GEMM || defined(PROBE_INFP8)
          pg8::gemm_phase<pg8::EpiInProj, pg8::StaticOrder, true, true, false, true>(F.lds + RING_OFF, g, S, E);
#endif
        }
        }
        if (BOTH(1)) GRID_BAR();
    }
    if (IN(2)) { REP(2) {
#if SSM_MFMA
        if (F.G == 256) {
            const int xcd = F.vcu >> 5, c = F.vcu & 31;
            for (int kk = 0; kk < 2; ++kk) ssm_mfma_item(F, args, ((c >> 4) + 2 * kk) * SG + 16 * xcd + (c & 15));
        } else for (int it = blockIdx.x; it < BATCH * SG; it += F.G) ssm_mfma_item(F, args, it);
#else
        for (int it = blockIdx.x; it < BATCH * SG; it += F.G) ssm_naive_item(F, args, it);
#endif
        __syncthreads();
        for (int it = blockIdx.x; it < BATCH * NH * MOBA_NB; it += F.G) kmean_item(F, it); __syncthreads(); }
        if (BOTH(2)) GRID_BAR();
    }
    if (IN(3)) { REP(3) {
        __syncthreads();
#if ATTN_MFMA
        attn_mfma_phase(F, lds);
#else
        for (int it = blockIdx.x; it < BATCH * NH * (SEQ / 8); it += F.G) attn_naive_item(F, it);
#endif
        }
    }
    if (IN(4)) { REP(4) {
        __syncthreads();
        pg8::Gemm g{(const pg8::bf16_t*)(F.ws + WS_YG), (const pg8::bf16_t*)(F.ws + WS_WGLU), T, SW, SW}; pg8::StaticOrder S; S.init(T, SW, F.G, (int)blockIdx.x);
        pg8::EpiGlu E{(const pg8::bf16_t*)(F.ws + WS_YG), (pg8::bf16_t*)(F.ws + WS_YCAT), (float*)(F.ctl + CW_SSQS)};
        pg8::gemm_phase<pg8::EpiGlu, pg8::StaticOrder, true, true>(F.lds + RING_OFF, g, S, E);
#if PROBE_GEMM
        pg8::gemm_phase<pg8::EpiGlu, pg8::StaticOrder, true, true>(F.lds + RING_OFF, g, S, E);
#endif
        }
        if (BOTH(4)) GRID_BAR();
    }
    if (IN(6)) { REP(6) {
        pg8::Gemm g{(const pg8::bf16_t*)(F.ws + WS_YCAT), (const pg8::bf16_t*)(F.ws + WS_WOUT), T, DM, DM}; pg8::StaticOrder S; S.init(T, DM, F.G, (int)blockIdx.x);
        pg8::EpiOutProj E{args.in[I_X], (pg8::bf16_t*)(F.ws + WS_X1BF), rep_ ? nullptr : (float*)(F.ctl + CW_SSQ1), (const float*)(F.ctl + CW_SSQAT), (const float*)(F.ctl + CW_SSQS), F.ws + WS_X1F8};
        pg8::gemm_phase<pg8::EpiOutProj, pg8::StaticOrder, true, true, true, true>(F.lds + RING_OFF, g, S, E);
#if PROBE_GEMM
        { pg8::EpiOutProj E2{args.in[I_X], (pg8::bf16_t*)(F.ws + WS_X1BF), nullptr, (const float*)(F.ctl + CW_SSQAT), (const float*)(F.ctl + CW_SSQS), F.ws + WS_X1F8}; pg8::gemm_phase<pg8::EpiOutProj, pg8::StaticOrder, true, true, true, true>(F.lds + RING_OFF, g, S, E2); }
#endif
        }
        if (BOTH(6)) GRID_BAR();
    }
    if (IN(7)) {
        pg8::Gemm g{(const pg8::bf16_t*)(F.ws + WS_X1F8), (const pg8::bf16_t*)(F.ws + WS_WQ), T, 2048, DM}; pg8::StaticOrder S; S.init(T, 2048, F.G, (int)blockIdx.x);
        pg8::EpiPeerQ E{(const float*)(F.ctl + CW_SSQ1), (pg8::bf16_t*)(F.ws + WS_QP)};
        pg8::gemm_phase<pg8::EpiPeerQ, pg8::StaticOrder, true, true, false, true>(F.lds + RING_OFF, g, S, E);
#if PROBE_GEMM
        pg8::gemm_phase<pg8::EpiPeerQ, pg8::StaticOrder, true, true, false, true>(F.lds + RING_OFF, g, S, E);
#endif
        const bool fused78 = (F.G == (T / 256) * (2048 / 256)) && IN(8);
        if (fused78) {
            pg8::Unit u; S.next(0, u);
            asm volatile("s_waitcnt vmcnt(0)" ::: "memory"); __syncthreads();
            topk_mfma_item(F, (2 * u.pm) * PH + u.pn, true); topk_mfma_item(F, (2 * u.pm + 1) * PH + u.pn, false);
#ifdef PROBE_TK
            topk_mfma_item(F, (2 * u.pm) * PH + u.pn, true); topk_mfma_item(F, (2 * u.pm + 1) * PH + u.pn, false);
#endif
            peer_xq_phase(F);
            if (BOTH(8)) GRID_BAR();
        } else if (BOTH(7)) GRID_BAR();
    }
    if (IN(8) && !(IN(7) && F.G == (T / 256) * (2048 / 256))) { REP(8) {
        __syncthreads();
        for (int it = F.vcu; it < (T / 128) * PH; it += F.G) topk_mfma_item(F, it);
        }
        peer_xq_phase(F);
        if (BOTH(8)) GRID_BAR();
    }
    if (IN(9)) { REP(9) { peer_u_phase(F); } if (BOTH(9)) GRID_BAR(); }
    if (IN(10)) { REP(10) { peer_combine_phase(F); } if (BOTH(10)) GRID_BAR(); }
    if (IN(11)) { REP(11) { __syncthreads(); peer_v_phase(F); } if (BOTH(11)) GRID_BAR(); }
    if (IN(12)) { REP(12) { final_norm_phase(F, args); } }
#undef IN
#undef BOTH
#undef GRID_BAR
}

extern "C" void kernel_launch(void* const* d_in, const int* in_sizes, int n_in, void* d_out, int out_size, void* d_ws, size_t ws_size, hipStream_t stream) {
    static int grid = 0;
    if (grid == 0) {
        if (n_in != 23 || in_sizes[0] != T * DM || out_size != T * DM || ws_size < WS_END) { fprintf(stderr, "kernel_launch: unexpected shapes (n_in %d, in0 %d, out %d, ws %zu)\n", n_in, n_in > 0 ? in_sizes[0] : -1, out_size, ws_size); grid = -1; return; }
        int dev = 0, cus = 0, per_cu = 0;
        if (hipGetDevice(&dev) != hipSuccess || hipDeviceGetAttribute(&cus, hipDeviceAttributeMultiprocessorCount, dev) != hipSuccess) { grid = -1; return; }
        if (hipFuncSetAttribute((const void*)fwd_kernel, hipFuncAttributeMaxDynamicSharedMemorySize, LDS_BYTES) != hipSuccess) { fprintf(stderr, "kernel_launch: hipFuncSetAttribute failed\n"); grid = -1; return; }
        if (hipOccupancyMaxActiveBlocksPerMultiprocessor(&per_cu, (const void*)fwd_kernel, NWAVES * 64, LDS_BYTES) != hipSuccess || per_cu < 1)
            fprintf(stderr, "kernel_launch: occupancy query reports %d workgroups per CU\n", per_cu);
        (void)hipGetLastError();
        grid = cus;
    }
    if (grid < 0) return;
    if (hipMemsetAsync((char*)d_ws + WS_CTL, 0, CTL_ZERO_BYTES, stream) != hipSuccess) return;
    Args a{};
    for (int i = 0; i < 23; ++i) a.in[i] = (const float*)d_in[i];
    a.out = (float*)d_out; a.ws = (unsigned char*)d_ws;
    if (MK_N_LAUNCHES == 1) { a.ph_lo = 0; a.ph_hi = N_PHASES; hipLaunchKernelGGL(fwd_kernel, dim3(grid), dim3(NWAVES * 64), LDS_BYTES, stream, a); }
    else for (int p = 0; p < N_PHASES; ++p) { a.ph_lo = p; a.ph_hi = p + 1; hipLaunchKernelGGL(fwd_kernel, dim3(grid), dim3(NWAVES * 64), LDS_BYTES, stream, a); }
}
```
